# Optimizing an MI355X kernel written in HIP

```python
import math
import jax
import jax.numpy as jnp
from jax import lax
import numpy as np

D_MODEL = 1024
BATCH = 4
SEQ = 4096
DEPTH = 4
DEC_BATCH = 32
DEC_SEQ = 32
PAST_LEN = 1024

CHUNK = 64
N_META = 16
EPS = 1e-6
H_FOX = 6
HD_FOX = 64
D_FOX = H_FOX * HD_FOX
Q_BLOCK = 128
POOL_WINDOWS = (2, 4, 8, 16)
N_POOL_GROUPS = 4
POOL_GROUP_DIM = 64
D_POOL = N_POOL_GROUPS * POOL_GROUP_DIM
POOL_BUF = 15
H_SSD = 6
HD_SSD = 64
D_SSD = H_SSD * HD_SSD
N_BC_GROUPS = 2
D_STATE = 64
CONV_W = 4
D_CONV = D_SSD + 2 * N_BC_GROUPS * D_STATE
D_MIX = D_FOX + D_POOL + D_SSD
SPLIT_SIZES = (D_FOX, D_FOX, D_FOX, H_FOX, D_POOL, D_SSD, D_CONV, H_SSD)
N_IN = D_FOX * 3 + H_FOX + D_POOL + D_SSD + D_CONV + H_SSD
D_FF = ((8 * D_MODEL + 3 * 256 - 1) // (3 * 256)) * 256

kernel_name = "hymba_fox_pool_ssd_streaming_step"


def rmsnorm(x, g):
    xf = x.astype(jnp.float32)
    y = xf * lax.rsqrt(jnp.mean(xf * xf, axis=-1, keepdims=True) + EPS)
    return (y * g.astype(jnp.float32)).astype(x.dtype)


def split_points():
    pts, acc = [], 0
    for s in SPLIT_SIZES[:-1]:
        acc += s
        pts.append(acc)
    return pts


def fox_block(q, k, v, c_q, c_k, q_pos, k_pos):
    s = jnp.einsum('bqhd,bkhd->bhqk', q, k).astype(jnp.float32) * (HD_FOX ** -0.5)
    s = s + jnp.transpose(c_q, (0, 2, 1))[:, :, :, None] - jnp.transpose(c_k, (0, 2, 1))[:, :, None, :]
    mask = (k_pos[None, :] <= q_pos[:, None])[None, None]
    p = jax.nn.softmax(jnp.where(mask, s, -jnp.inf), axis=-1)
    return jnp.einsum('bhqk,bkhd->bqhd', p.astype(v.dtype), v)


def fox_prompt(q, k, v, logf):
    b, t = q.shape[0], q.shape[1]
    c = jnp.cumsum(logf, axis=1)
    nb = -(-t // Q_BLOCK)
    tp = nb * Q_BLOCK
    pad = tp - t
    padt = lambda a: jnp.pad(a, [(0, 0), (0, pad)] + [(0, 0)] * (a.ndim - 2))
    qp, kp, vp, cp = padt(q), padt(k), padt(v), padt(c)
    k_pos = jnp.arange(tp)

    def one_block(i):
        s0 = i * Q_BLOCK
        qb = lax.dynamic_slice_in_dim(qp, s0, Q_BLOCK, axis=1)
        cb = lax.dynamic_slice_in_dim(cp, s0, Q_BLOCK, axis=1)
        return fox_block(qb, kp, vp, cb, cp, s0 + jnp.arange(Q_BLOCK), k_pos)

    out = lax.map(one_block, jnp.arange(nb))
    out = jnp.moveaxis(out, 0, 1).reshape(b, tp, H_FOX, HD_FOX)
    return out[:, :t]


def fox_sample(q, k, v, logf, ck, cv, cl):
    p_len, s_len = ck.shape[1], q.shape[1]
    k_all = jnp.concatenate([ck.astype(k.dtype), k], axis=1)
    v_all = jnp.concatenate([cv.astype(v.dtype), v], axis=1)
    c_all = jnp.cumsum(jnp.concatenate([cl.astype(jnp.float32), logf], axis=1), axis=1)
    return fox_block(q, k_all, v_all, c_all[:, p_len:], c_all,
                     p_len + jnp.arange(s_len), jnp.arange(p_len + s_len))


def pool_mixer(u, prefix, pos0, w_pool, scale):
    b, L, _ = u.shape
    ext = jnp.concatenate([prefix.astype(u.dtype), u], axis=1)
    csum = jnp.pad(jnp.cumsum(ext.astype(jnp.float32), axis=1), ((0, 0), (1, 0), (0, 0)))
    end = csum[:, POOL_BUF + 1:]
    pos = pos0 + jnp.arange(L)
    parts = []
    for g, w in enumerate(POOL_WINDOWS):
        lo, hi = g * POOL_GROUP_DIM, (g + 1) * POOL_GROUP_DIM
        start = csum[:, POOL_BUF + 1 - w:POOL_BUF + 1 - w + L, lo:hi]
        cnt = jnp.minimum(pos + 1, w).astype(jnp.float32)[None, :, None]
        parts.append((end[:, :, lo:hi] - start) / cnt)
    diff = jnp.concatenate(parts, axis=-1) - u.astype(jnp.float32)
    y = jnp.einsum('blgc,gce->blge', diff.reshape(b, L, N_POOL_GROUPS, POOL_GROUP_DIM),
                   w_pool.astype(jnp.float32)).reshape(b, L, D_POOL)
    y = y * scale.astype(jnp.float32)
    return y.astype(u.dtype), ext[:, -POOL_BUF:]


def causal_conv(xbc, prefix, w, bias):
    L = xbc.shape[1]
    ext = jnp.concatenate([prefix.astype(xbc.dtype), xbc], axis=1)
    out = bias
    for j in range(CONV_W):
        out = out + ext[:, j:j + L] * w[j]
    return jax.nn.silu(out), ext[:, -(CONV_W - 1):]


def ssd_scan(xs, dt, a, bm, cm, init, block):
    b, L, h, p = xs.shape
    n = bm.shape[-1]
    nc = L // block
    rep = h // bm.shape[2]
    bh = jnp.repeat(bm, rep, axis=2).reshape(b, nc, block, h, n)
    ch = jnp.repeat(cm, rep, axis=2).reshape(b, nc, block, h, n)
    la = (dt * a).reshape(b, nc, block, h)
    xd = (xs * dt[..., None]).reshape(b, nc, block, h, p)
    a_cs = jnp.cumsum(la, axis=2)
    seg = a_cs[:, :, :, None, :] - a_cs[:, :, None, :, :]
    causal = jnp.tril(jnp.ones((block, block), dtype=bool))[None, None, :, :, None]
    lmat = jnp.exp(jnp.where(causal, seg, -jnp.inf))
    gmat = jnp.einsum('bcqhn,bcshn->bcqsh', ch, bh) * lmat
    y_diag = jnp.einsum('bcqsh,bcshp->bcqhp', gmat, xd)
    decay_end = jnp.exp(a_cs[:, :, -1:, :] - a_cs)
    chunk_states = jnp.einsum('bcshn,bcsh,bcshp->bchpn', bh, decay_end, xd)
    chunk_decay = jnp.exp(a_cs[:, :, -1, :])

    def step(state, inp):
        dec, st = inp
        return dec[:, :, None, None] * state + st, state

    final, prev = lax.scan(step, init, (jnp.moveaxis(chunk_decay, 1, 0), jnp.moveaxis(chunk_states, 1, 0)))
    prev = jnp.moveaxis(prev, 0, 1)
    y_off = jnp.einsum('bcqhn,bchpn->bcqhp', ch, prev) * jnp.exp(a_cs)[..., None]
    return (y_diag + y_off).reshape(b, L, h, p), final


def trunk_layer(x, params, state, pos0):
    (ln_pre_mix, ln_post_mix, ln_pre_ffn, ln_post_ffn, w_in, fox_f_bias, pool_w, pool_scale,
     conv_w, conv_b, dt_bias, a_log, d_skip, ssd_norm, w_out, w_gate, w_up, w_down) = params
    f32 = jnp.float32
    b, L, _ = x.shape
    h = rmsnorm(x, ln_pre_mix)
    proj = h @ w_in
    q, k, v, f_raw, u, z, xbc, dt_raw = jnp.split(proj, split_points(), axis=-1)
    q = q.reshape(b, L, H_FOX, HD_FOX)
    k = k.reshape(b, L, H_FOX, HD_FOX)
    v = v.reshape(b, L, H_FOX, HD_FOX)
    logf = jax.nn.log_sigmoid(f_raw.astype(f32) + fox_f_bias.astype(f32))
    if state is None:
        attn = fox_prompt(q, k, v, logf)
        pool_prefix = jnp.zeros((b, POOL_BUF, D_POOL), x.dtype)
        conv_prefix = jnp.zeros((b, CONV_W - 1, D_CONV), x.dtype)
        ssd_init = jnp.zeros((b, H_SSD, HD_SSD, D_STATE), f32)
        ssd_pad = (-L) % CHUNK
        block = CHUNK
    else:
        ck, cv, cl, pool_prefix, conv_prefix, ssd_init = state
        attn = fox_sample(q, k, v, logf, ck, cv, cl)
        ssd_pad = 0
        block = L
    pool_out, pool_new = pool_mixer(u, pool_prefix, pos0, pool_w, pool_scale)
    xbc_a, conv_new = causal_conv(xbc, conv_prefix, conv_w, conv_b)
    nbc = N_BC_GROUPS * D_STATE
    xs = xbc_a[..., :D_SSD].reshape(b, L, H_SSD, HD_SSD).astype(f32)
    bm = xbc_a[..., D_SSD:D_SSD + nbc].reshape(b, L, N_BC_GROUPS, D_STATE).astype(f32)
    cm = xbc_a[..., D_SSD + nbc:].reshape(b, L, N_BC_GROUPS, D_STATE).astype(f32)
    dt = jax.nn.softplus(dt_raw.astype(f32) + dt_bias.astype(f32))
    a = -jnp.exp(a_log.astype(f32))
    lpad = lambda t: jnp.pad(t, [(0, 0), (ssd_pad, 0)] + [(0, 0)] * (t.ndim - 2))
    y, ssd_new = ssd_scan(lpad(xs), lpad(dt), a, lpad(bm), lpad(cm), ssd_init.astype(f32), block)
    y = y[:, ssd_pad:] + d_skip.astype(f32)[:, None] * xs
    y = y.reshape(b, L, D_SSD) * jax.nn.silu(z.astype(f32))
    ssd_out = rmsnorm(y, ssd_norm).astype(x.dtype)
    mix = jnp.concatenate([attn.reshape(b, L, D_FOX).astype(x.dtype), pool_out.astype(x.dtype), ssd_out], axis=-1)
    x = x + rmsnorm(mix @ w_out, ln_post_mix)
    h = rmsnorm(x, ln_pre_ffn)
    ff = (jax.nn.silu(h @ w_gate) * (h @ w_up)) @ w_down
    x = x + rmsnorm(ff, ln_post_ffn)
    return x, (k, v, logf, pool_new, conv_new, ssd_new)


def setup_inputs(seed: int = 0) -> dict:
    key = jax.random.key(seed)
    ks = jax.random.split(key, 32)
    nrm = lambda i, shape, s=1.0: s * jax.random.normal(ks[i], shape, jnp.float32)
    u01 = jax.random.uniform(ks[20], (DEPTH, H_SSD), jnp.float32)
    dt0 = jnp.exp(u01 * (math.log(0.1) - math.log(0.001)) + math.log(0.001))
    return {
        'x_prompt': nrm(0, (BATCH, SEQ, D_MODEL)),
        'x_sample': nrm(1, (DEC_BATCH, DEC_SEQ, D_MODEL)),
        'cache_fox_k': nrm(2, (DEPTH, DEC_BATCH, PAST_LEN, H_FOX, HD_FOX)),
        'cache_fox_v': nrm(3, (DEPTH, DEC_BATCH, PAST_LEN, H_FOX, HD_FOX)),
        'cache_fox_logf': jax.nn.log_sigmoid(nrm(4, (DEPTH, DEC_BATCH, PAST_LEN, H_FOX)) + 2.0),
        'state_pool': nrm(5, (DEPTH, DEC_BATCH, POOL_BUF, D_POOL)),
        'state_conv': nrm(6, (DEPTH, DEC_BATCH, CONV_W - 1, D_CONV)),
        'state_ssd': nrm(7, (DEPTH, DEC_BATCH, H_SSD, HD_SSD, D_STATE), 0.1),
        'meta_tokens': nrm(8, (N_META, D_MODEL)),
        'ln_pre_mix': 1.0 + nrm(9, (DEPTH, D_MODEL), 0.05),
        'ln_post_mix': 1.0 + nrm(10, (DEPTH, D_MODEL), 0.05),
        'ln_pre_ffn': 1.0 + nrm(11, (DEPTH, D_MODEL), 0.05),
        'ln_post_ffn': 1.0 + nrm(12, (DEPTH, D_MODEL), 0.05),
        'w_in': nrm(13, (DEPTH, D_MODEL, N_IN), D_MODEL ** -0.5),
        'fox_f_bias': nrm(14, (DEPTH, H_FOX), 0.1),
        'pool_w': nrm(15, (DEPTH, N_POOL_GROUPS, POOL_GROUP_DIM, POOL_GROUP_DIM), POOL_GROUP_DIM ** -0.5),
        'pool_scale': 1.0 + nrm(16, (DEPTH, D_POOL), 0.05),
        'conv_w': nrm(17, (DEPTH, CONV_W, D_CONV), CONV_W ** -0.5),
        'conv_b': nrm(18, (DEPTH, D_CONV), 0.01),
        'dt_bias': dt0 + jnp.log(-jnp.expm1(-dt0)),
        'a_log': jnp.log(jax.random.uniform(ks[21], (DEPTH, H_SSD), jnp.float32, 1.0, 16.0)),
        'd_skip': 1.0 + nrm(22, (DEPTH, H_SSD), 0.05),
        'ssd_norm': 1.0 + nrm(23, (DEPTH, D_SSD), 0.05),
        'w_out': nrm(24, (DEPTH, D_MIX, D_MODEL), D_MIX ** -0.5),
        'w_gate': nrm(25, (DEPTH, D_MODEL, D_FF), D_MODEL ** -0.5),
        'w_up': nrm(26, (DEPTH, D_MODEL, D_FF), D_MODEL ** -0.5),
        'w_down': nrm(27, (DEPTH, D_FF, D_MODEL), D_FF ** -0.5),
    }


def reference(x_prompt, x_sample, cache_fox_k, cache_fox_v, cache_fox_logf, state_pool, state_conv,
              state_ssd, meta_tokens, ln_pre_mix, ln_post_mix, ln_pre_ffn, ln_post_ffn, w_in,
              fox_f_bias, pool_w, pool_scale, conv_w, conv_b, dt_bias, a_log, d_skip, ssd_norm,
              w_out, w_gate, w_up, w_down):
    weights = (ln_pre_mix, ln_post_mix, ln_pre_ffn, ln_post_ffn, w_in, fox_f_bias, pool_w, pool_scale,
               conv_w, conv_b, dt_bias, a_log, d_skip, ssd_norm, w_out, w_gate, w_up, w_down)
    past = cache_fox_k.shape[2]
    meta = jnp.broadcast_to(meta_tokens.astype(x_prompt.dtype)[None],
                            (x_prompt.shape[0], N_META, D_MODEL))
    xp = jnp.concatenate([meta, x_prompt], axis=1)
    xs = x_sample
    new_p, new_s = [], []
    for l in range(DEPTH):
        p_l = tuple(w[l] for w in weights)
        xp, st_p = trunk_layer(xp, p_l, None, 0)
        xs, st_s = trunk_layer(xs, p_l, (cache_fox_k[l], cache_fox_v[l], cache_fox_logf[l],
                                         state_pool[l], state_conv[l], state_ssd[l]), past)
        new_p.append(st_p)
        new_s.append(st_s)
    stk = lambda lst, i: jnp.stack([s[i] for s in lst], axis=0)
    y_prompt = xp[:, N_META:]
    return (y_prompt, xs,
            stk(new_p, 0), stk(new_p, 1), stk(new_p, 2), stk(new_p, 3), stk(new_p, 4), stk(new_p, 5),
            stk(new_s, 0), stk(new_s, 1), stk(new_s, 2), stk(new_s, 3), stk(new_s, 4), stk(new_s, 5))
```

```cpp
#include <hip/hip_runtime.h>
#include <hip/hip_cooperative_groups.h>
#include <cstdio>
#include <cstdint>
namespace pg8 {
#define PG8_LAS __attribute__((address_space(3)))
typedef unsigned short bf16_t;
typedef short bf16x8 __attribute__((ext_vector_type(8)));
typedef float f32x4 __attribute__((ext_vector_type(4)));
typedef unsigned u32x4 __attribute__((ext_vector_type(4)));
constexpr int BM = 256, BK = 64, HALF = 128, HTB = HALF * BK * 2  , STAGE_BYTES = 8 * HTB, NXCD = 8, WGM = 8;

__host__ __device__ __forceinline__ int lds_byte(int r, int c) { const int st = (r >> 4) * 2 + (c >> 5), rr = r & 15, cc = c & 31, ob = rr * 64 + cc * 2; return st * 1024 + (ob ^ (((ob >> 9) & 1) << 5)); }
__host__ __device__ __forceinline__ void stage_rc(int b, int& R, int& C) { const int st = b / 1024, sb = b % 1024, swz = sb ^ (((sb >> 9) & 1) << 5); R = (st >> 1) * 16 + swz / 64; C = (st & 1) * 32 + (swz % 64) / 2; }
__host__ __device__ __forceinline__ int perm32(int rho) { const int n = rho >> 4, i = rho & 15; return 8 * (i >> 2) + 4 * n + (i & 3); }

struct Unit { int pm, pn; };
struct Gemm { const bf16_t* A; const bf16_t* Bt; int M, N, K; };

struct StaticOrder {
    int nM, nN, nwg, G, c;
    __host__ __device__ void init(int M, int N, int G_, int c_) { nM = M / BM; nN = N / BM; nwg = nM * nN; G = G_; c = c_; }
    __host__ __device__ bool next(int i, Unit& u) const {
        const long L = (long)i * G + c; if (L >= nwg) return false;
        int wgid = (int)L; { const int q = nwg / NXCD, r = nwg % NXCD, xcd = wgid % NXCD, off = wgid / NXCD; wgid = (xcd < r ? xcd * (q + 1) : r * (q + 1) + (xcd - r) * q) + off; }
        const int nig = WGM * nN, gid = wgid / nig, fm = gid * WGM, gsz = (nM - fm) < WGM ? (nM - fm) : WGM;
        u.pm = fm + ((wgid % nig) % gsz); u.pn = (wgid % nig) / gsz; return true;
    }
    __device__ __forceinline__ void a_ready(const Unit&) const {}
    __device__ __forceinline__ void done(const Unit&) const {}
};

template <class Epi, class Sched, bool STAMP = false>
__device__ __forceinline__ void gemm_phase(PG8_LAS unsigned char* lds, const Gemm g, const Sched& S, const Epi& E, unsigned long long* stamps) {
    int tid_ = threadIdx.x; asm volatile("" : "+v"(tid_));
    const int tid = tid_, wid = __builtin_amdgcn_readfirstlane(tid >> 6), lane = tid & 63, wr = wid >> 2, wc = wid & 3, fr = lane & 15, fq = lane >> 4;
    const int K = g.K, nt = K / BK;
    int ts_lo = 0, ts_hi = 0, nts = 0; const unsigned long long rt_entry = STAMP ? (unsigned long long)wall_clock64() : 0ull;
#define PG8_STAMP() do { if (STAMP && wid == 0 && nts < 64) { const unsigned long long _c = (unsigned long long)clock64(); \
        ts_lo = (lane == nts) ? (int)(unsigned)_c : ts_lo; ts_hi = (lane == nts) ? (int)(unsigned)(_c >> 32) : ts_hi; ++nts; } } while (0)
    PG8_STAMP();
    unsigned voffA[2], voffB[2];
#pragma unroll
    for (int i = 0; i < 2; ++i) { int R, C; stage_rc(tid * 16 + i * 8192, R, C); const int Rb = Epi::PERM ? ((R & ~31) + perm32(R & 31)) : R;
        voffA[i] = (unsigned)(R * K + C) * 2u; voffB[i] = (unsigned)(Rb * K + C) * 2u; }
    const size_t kstep = (size_t)(BK * 2);
    const size_t hstep = (size_t)HALF * K * 2;
    const size_t tstep = 2 * hstep;
    const unsigned ldsw = (unsigned)wid * 1024u;
    const int aoff = lds_byte(wr * 64 + fr, fq * 8), boff = lds_byte(wc * 32 + fr, fq * 8);
#define PG8_SA(b, h) (((b) * 2 + (h)) * HTB)
#define PG8_SB(b, h) ((4 + (b) * 2 + (h)) * HTB)
#define PG8_STAGE(bufoff, gbase, voff) do { _Pragma("unroll") for (int _i = 0; _i < 2; ++_i) \
        __builtin_amdgcn_global_load_lds((const unsigned*)((const char*)(gbase) + (voff)[_i]), (PG8_LAS unsigned*)(lds + (bufoff) + ldsw + _i * 8192), 16, 0, 0); } while (0)
#define PG8_LDA(dst, b, h) do { _Pragma("unroll") for (int m = 0; m < 4; ++m) _Pragma("unroll") for (int k = 0; k < 2; ++k) dst[m][k] = *(const PG8_LAS bf16x8*)(lds + PG8_SA(b, h) + aoff + m * 2048 + k * 1024); } while (0)
#define PG8_LDB(dst, b, h) do { _Pragma("unroll") for (int n = 0; n < 2; ++n) _Pragma("unroll") for (int k = 0; k < 2; ++k) dst[n][k] = *(const PG8_LAS bf16x8*)(lds + PG8_SB(b, h) + boff + n * 2048 + k * 1024); } while (0)
#define PG8_MMA(ai, bj, At, Bt) do { __builtin_amdgcn_s_setprio(1); _Pragma("unroll") for (int m = 0; m < 4; ++m) _Pragma("unroll") for (int n = 0; n < 2; ++n) _Pragma("unroll") for (int k = 0; k < 2; ++k) \
        acc[ai][bj][m][n] = __builtin_amdgcn_mfma_f32_16x16x32_bf16(Bt[n][k], At[m][k], acc[ai][bj][m][n], 0, 0, 0); __builtin_amdgcn_s_setprio(0); } while (0)
#define PG8_WAIT_V(n) asm volatile("s_waitcnt vmcnt(" #n ")" ::: "memory")
#define PG8_WAIT_L(n) asm volatile("s_waitcnt lgkmcnt(" #n ")" ::: "memory")
#define PG8_BAR __builtin_amdgcn_s_barrier()
#define PG8_SCHED __builtin_amdgcn_sched_barrier(0)
    Unit cur, nxt; int ui = 0;
    if (!S.next(0, cur)) return;
    f32x4 acc[2][2][4][2];
#pragma unroll
    for (int a = 0; a < 2; ++a)
#pragma unroll
        for (int b = 0; b < 2; ++b)
#pragma unroll
            for (int m = 0; m < 4; ++m)
#pragma unroll
                for (int n = 0; n < 2; ++n) acc[a][b][m][n] = (f32x4){0.f, 0.f, 0.f, 0.f};
    bf16x8 At[4][2], B0[2][2], B1[2][2];
    const char* cA = (const char*)g.A + (size_t)cur.pm * tstep; const char* cB = (const char*)g.Bt + (size_t)cur.pn * tstep;
    S.a_ready(cur);
    PG8_STAGE(PG8_SB(0, 0), cB, voffB); PG8_STAGE(PG8_SA(0, 0), cA, voffA); PG8_STAGE(PG8_SB(0, 1), cB + hstep, voffB); PG8_STAGE(PG8_SA(0, 1), cA + hstep, voffA);
    if (wr == 1) PG8_BAR;
    PG8_WAIT_V(4); PG8_BAR;
    PG8_STAGE(PG8_SB(1, 0), cB + kstep, voffB); PG8_STAGE(PG8_SA(1, 0), cA + kstep, voffA); PG8_STAGE(PG8_SB(1, 1), cB + hstep + kstep, voffB);
    PG8_WAIT_V(6); PG8_BAR;
    PG8_STAMP();
    for (;;) {
        const bool has_next = S.next(ui + 1, nxt);
        const char* nA = has_next ? (const char*)g.A + (size_t)nxt.pm * tstep : cA; const char* nB = has_next ? (const char*)g.Bt + (size_t)nxt.pn * tstep : cB;
        for (int t = 0; t < nt; t += 2) {
            const bool last = (t == nt - 2);
            const char* a1 = cA + (size_t)(t + 1) * kstep;
            const char* a2 = last ? nA : cA + (size_t)(t + 2) * kstep; const char* b2 = last ? nB : cB + (size_t)(t + 2) * kstep;
            const char* a3 = a2 + kstep; const char* b3 = b2 + kstep;
            if (last && has_next) S.a_ready(nxt);
            PG8_LDB(B0, 0, 0); PG8_SCHED; PG8_LDA(At, 0, 0); PG8_STAGE(PG8_SA(1, 1), a1 + hstep, voffA);
            PG8_WAIT_L(8); PG8_BAR; PG8_WAIT_L(0); PG8_MMA(0, 0, At, B0); PG8_BAR; PG8_SCHED;
            PG8_LDB(B1, 0, 1); PG8_STAGE(PG8_SB(0, 0), b2, voffB);
            PG8_BAR; PG8_WAIT_L(0); PG8_MMA(0, 1, At, B1); PG8_BAR;
            PG8_LDA(At, 0, 1); PG8_STAGE(PG8_SA(0, 0), a2, voffA);
            PG8_BAR; PG8_WAIT_L(0); PG8_MMA(1, 0, At, B0); PG8_BAR; PG8_SCHED;
            PG8_STAGE(PG8_SB(0, 1), b2 + hstep, voffB);
            PG8_WAIT_V(6); PG8_BAR; PG8_MMA(1, 1, At, B1); PG8_BAR;
            PG8_LDB(B0, 1, 0); PG8_SCHED; PG8_LDA(At, 1, 0); PG8_STAGE(PG8_SA(0, 1), a2 + hstep, voffA);
            PG8_WAIT_L(8); PG8_BAR; PG8_WAIT_L(0); PG8_MMA(0, 0, At, B0); PG8_BAR; PG8_SCHED;
            PG8_LDB(B1, 1, 1); PG8_STAGE(PG8_SB(1, 0), b3, voffB);
            PG8_BAR; PG8_WAIT_L(0); PG8_MMA(0, 1, At, B1); PG8_BAR;
            PG8_LDA(At, 1, 1); PG8_STAGE(PG8_SA(1, 0), a3, voffA);
            PG8_BAR; PG8_WAIT_L(0); PG8_MMA(1, 0, At, B0); PG8_BAR; PG8_SCHED;
            PG8_STAGE(PG8_SB(1, 1), b3 + hstep, voffB);
            PG8_WAIT_V(6); PG8_BAR; PG8_MMA(1, 1, At, B1); PG8_BAR;
        }
        PG8_STAMP();
        if constexpr (!Epi::AFTER_DRAIN) { E(acc, cur, wr, wc, fr, fq); S.done(cur); }
        PG8_STAMP();
        if (!has_next) break;
#pragma unroll
        for (int a = 0; a < 2; ++a)
#pragma unroll
            for (int b = 0; b < 2; ++b)
#pragma unroll
                for (int m = 0; m < 4; ++m)
#pragma unroll
                    for (int n = 0; n < 2; ++n) acc[a][b][m][n] = (f32x4){0.f, 0.f, 0.f, 0.f};
        cur = nxt; cA = nA; cB = nB; ++ui;
    }
    PG8_WAIT_V(0);
    if (wr == 0) PG8_BAR;
    PG8_BAR;
    if constexpr (Epi::AFTER_DRAIN) { E.fused(acc, cur, wr, wc, fr, fq, lds, wid, lane); S.done(cur); }
    PG8_STAMP();
    if (STAMP && wid == 0) { stamps[lane] = lane < nts ? (((unsigned long long)(unsigned)ts_hi << 32) | (unsigned)ts_lo) : 0ull;
        if (lane == 62) stamps[62] = rt_entry; if (lane == 63) stamps[63] = (unsigned long long)wall_clock64(); }
#undef PG8_STAMP
#undef PG8_SA
#undef PG8_SB
#undef PG8_STAGE
#undef PG8_LDA
#undef PG8_LDB
#undef PG8_MMA
#undef PG8_WAIT_V
#undef PG8_WAIT_L
#undef PG8_BAR
#undef PG8_SCHED
}
}
namespace cg = cooperative_groups;
using pg8::bf16_t; using pg8::bf16x8; using pg8::f32x4; using pg8::u32x4;
typedef float f32x16 __attribute__((ext_vector_type(16)));
typedef unsigned u32x2 __attribute__((ext_vector_type(2)));
#define MFMA32(a, b, c) __builtin_amdgcn_mfma_f32_32x32x16_bf16((a), (b), (c), 0, 0, 0)
#define DI __device__ __forceinline__

constexpr int DMODEL = 1024, NB = 4, SEQ = 4096, NMETA = 16, TP = SEQ + NMETA, DEPTH = 4, DB = 32, DS = 32, PAST = 1024;
constexpr int MP = NB * TP, MS = DB * DS, MTOT = MP + MS, MPAD = 17664;
constexpr int NPROJ = 2560, DFF = 2816, NCH = 65;
constexpr int CK_ = 384, CV_ = 768, CU_ = 1152, CZ_ = 1408, CX_ = 1792, CF_ = 2432, CDT_ = 2440;
constexpr float EPS = 1e-6f, LOG2E = 1.4426950408889634f, QSCALE = 0.125f * 1.4426950408889634f;
constexpr size_t OFF_Y = 0, OFF_YS = OFF_Y + (size_t)NB * SEQ * 1024, OFF_KP = OFF_YS + (size_t)DB * DS * 1024,
                 OFF_VP = OFF_KP + (size_t)DEPTH * MP * 384, OFF_LP = OFF_VP + (size_t)DEPTH * MP * 384, OFF_PP = OFF_LP + (size_t)DEPTH * MP * 6,
                 OFF_CP = OFF_PP + (size_t)DEPTH * NB * 15 * 256, OFF_SP = OFF_CP + (size_t)DEPTH * NB * 3 * 640, OFF_KS = OFF_SP + (size_t)DEPTH * NB * 6 * 4096,
                 OFF_VS = OFF_KS + (size_t)DEPTH * MS * 384, OFF_LS = OFF_VS + (size_t)DEPTH * MS * 384, OFF_PS = OFF_LS + (size_t)DEPTH * MS * 6,
                 OFF_CS = OFF_PS + (size_t)DEPTH * DB * 15 * 256, OFF_SS = OFF_CS + (size_t)DEPTH * DB * 3 * 640;
constexpr size_t al256(size_t x) { return (x + 255) & ~(size_t)255; }
constexpr size_t WS_CTR = 0, WS_WIN = 4096, SZ_WIN = (size_t)NPROJ * 1024 * 2, WS_WOUT = WS_WIN + DEPTH * SZ_WIN, SZ_WOUT = (size_t)1024 * 1024 * 2,
                 WS_WGU = WS_WOUT + DEPTH * SZ_WOUT, SZ_WGU = (size_t)2 * DFF * 1024 * 2, WS_WDN = WS_WGU + DEPTH * SZ_WGU, SZ_WDN = (size_t)1024 * DFF * 2,
                 WS_PWT = WS_WDN + DEPTH * SZ_WDN, WS_X = WS_PWT + (size_t)DEPTH * 4 * 4096 * 2, WS_H = WS_X + (size_t)MPAD * 1024 * 4,
                 WS_PROJ = WS_H + (size_t)MPAD * 1024 * 2, WS_VT = WS_PROJ + (size_t)MPAD * NPROJ * 2, WS_DT = WS_VT + al256((size_t)NB * 6 * 64 * 4160 * 2),
                 WS_MIX = WS_DT + (size_t)MPAD * 8 * 4, WS_OUT = WS_MIX + (size_t)MPAD * 1024 * 2, WS_HID = WS_OUT + (size_t)MPAD * 1024 * 4,
                 WS_Y32 = WS_HID + (size_t)MPAD * DFF * 2, WS_CC = WS_Y32 + (size_t)MPAD * 384 * 4, WS_ACS = WS_CC + (size_t)MPAD * 128 * 2,
                 WS_ST = WS_ACS + (size_t)MPAD * 8 * 4, WS_END = WS_ST + (size_t)NB * NCH * 6 * 4096 * 4;

struct Params {
    const float *x_prompt, *x_sample, *cache_k, *cache_v, *cache_logf, *state_pool, *state_conv, *state_ssd, *meta, *ln_pre_mix, *ln_post_mix, *ln_pre_ffn, *ln_post_ffn,
        *w_in, *fox_f_bias, *pool_w, *pool_scale, *conv_w, *conv_b, *dt_bias, *a_log, *d_skip, *ssd_norm, *w_out, *w_gate, *w_up, *w_down;
    float* out; unsigned char* ws;
};

typedef __attribute__((address_space(4))) const volatile unsigned long long kav_t;
__device__ __forceinline__ unsigned long long karg_raw(int idx) { kav_t* ka = (kav_t*)__builtin_amdgcn_kernarg_segment_ptr(); return ka[idx]; }
struct PV {
    __device__ __forceinline__ const float* x_prompt() const { return (const float*)(__attribute__((address_space(1))) const float*)karg_raw(0); }
    __device__ __forceinline__ const float* x_sample() const { return (const float*)(__attribute__((address_space(1))) const float*)karg_raw(1); }
    __device__ __forceinline__ const float* cache_k() const { return (const float*)(__attribute__((address_space(1))) const float*)karg_raw(2); }
    __device__ __forceinline__ const float* cache_v() const { return (const float*)(__attribute__((address_space(1))) const float*)karg_raw(3); }
    __device__ __forceinline__ const float* cache_logf() const { return (const float*)(__attribute__((address_space(1))) const float*)karg_raw(4); }
    __device__ __forceinline__ const float* state_pool() const { return (const float*)(__attribute__((address_space(1))) const float*)karg_raw(5); }
    __device__ __forceinline__ const float* state_conv() const { return (const float*)(__attribute__((address_space(1))) const float*)karg_raw(6); }
    __device__ __forceinline__ const float* state_ssd() const { return (const float*)(__attribute__((address_space(1))) const float*)karg_raw(7); }
    __device__ __forceinline__ const float* meta() const { return (const float*)(__attribute__((address_space(1))) const float*)karg_raw(8); }
    __device__ __forceinline__ const float* ln_pre_mix() const { return (const float*)(__attribute__((address_space(1))) const float*)karg_raw(9); }
    __device__ __forceinline__ const float* ln_post_mix() const { return (const float*)(__attribute__((address_space(1))) const float*)karg_raw(10); }
    __device__ __forceinline__ const float* ln_pre_ffn() const { return (const float*)(__attribute__((address_space(1))) const float*)karg_raw(11); }
    __device__ __forceinline__ const float* ln_post_ffn() const { return (const float*)(__attribute__((address_space(1))) const float*)karg_raw(12); }
    __device__ __forceinline__ const float* w_in() const { return (const float*)(__attribute__((address_space(1))) const float*)karg_raw(13); }
    __device__ __forceinline__ const float* fox_f_bias() const { return (const float*)(__attribute__((address_space(1))) const float*)karg_raw(14); }
    __device__ __forceinline__ const float* pool_w() const { return (const float*)(__attribute__((address_space(1))) const float*)karg_raw(15); }
    __device__ __forceinline__ const float* pool_scale() const { return (const float*)(__attribute__((address_space(1))) const float*)karg_raw(16); }
    __device__ __forceinline__ const float* conv_w() const { return (const float*)(__attribute__((address_space(1))) const float*)karg_raw(17); }
    __device__ __forceinline__ const float* conv_b() const { return (const float*)(__attribute__((address_space(1))) const float*)karg_raw(18); }
    __device__ __forceinline__ const float* dt_bias() const { return (const float*)(__attribute__((address_space(1))) const float*)karg_raw(19); }
    __device__ __forceinline__ const float* a_log() const { return (const float*)(__attribute__((address_space(1))) const float*)karg_raw(20); }
    __device__ __forceinline__ const float* d_skip() const { return (const float*)(__attribute__((address_space(1))) const float*)karg_raw(21); }
    __device__ __forceinline__ const float* ssd_norm() const { return (const float*)(__attribute__((address_space(1))) const float*)karg_raw(22); }
    __device__ __forceinline__ const float* w_out() const { return (const float*)(__attribute__((address_space(1))) const float*)karg_raw(23); }
    __device__ __forceinline__ const float* w_gate() const { return (const float*)(__attribute__((address_space(1))) const float*)karg_raw(24); }
    __device__ __forceinline__ const float* w_up() const { return (const float*)(__attribute__((address_space(1))) const float*)karg_raw(25); }
    __device__ __forceinline__ const float* w_down() const { return (const float*)(__attribute__((address_space(1))) const float*)karg_raw(26); }
    __device__ __forceinline__ float* out() const { return (float*)(__attribute__((address_space(1))) float*)karg_raw(27); }
    __device__ __forceinline__ unsigned char* ws() const { return (unsigned char*)(__attribute__((address_space(1))) unsigned char*)karg_raw(28); }
};

DI unsigned pack2(float lo, float hi) {
    typedef __bf16 bf2_t __attribute__((ext_vector_type(2))); typedef float fl2_t __attribute__((ext_vector_type(2)));
    fl2_t f = {lo, hi}; bf2_t b = __builtin_convertvector(f, bf2_t); return __builtin_bit_cast(unsigned, b);
}
DI float bf_lo(unsigned u) { return __uint_as_float(u << 16); }
DI float bf_hi(unsigned u) { return __uint_as_float(u & 0xffff0000u); }
DI bf16_t f2bf(float f) { return (bf16_t)(pack2(f, 0.f) & 0xffffu); }
DI float bf2f(bf16_t b) { return __uint_as_float(((unsigned)b) << 16); }
DI bf16x8 pack8(float a0, float a1, float a2, float a3, float a4, float a5, float a6, float a7) {
    u32x4 w = {pack2(a0, a1), pack2(a2, a3), pack2(a4, a5), pack2(a6, a7)}; return __builtin_bit_cast(bf16x8, w);
}
DI bf16x8 cat8(u32x2 lo, u32x2 hi) { u32x4 w = {lo.x, lo.y, hi.x, hi.y}; return __builtin_bit_cast(bf16x8, w); }
DI int crow(int i, int hi) { return (i & 3) + 8 * (i >> 2) + 4 * hi; }
DI float wave_sum(float v) {
#pragma unroll
    for (int o = 32; o > 0; o >>= 1) v += __shfl_xor(v, o);
    return v;
}
DI float wave_scan_incl(float v, int lane) {
#pragma unroll
    for (int o = 1; o < 64; o <<= 1) { const float t = __shfl_up(v, o); if (lane >= o) v += t; }
    return v;
}
DI float siluf(float x) { return x * __builtin_amdgcn_rcpf(1.f + __expf(-x)); }
DI float ex2(float x) { return __builtin_amdgcn_exp2f(x); }

DI int map_in_col(int n) {
    if (n < 1152) return n;
    if (n < 1408) return 1158 + (n - 1152);
    if (n < 1792) return 1414 + (n - 1408);
    if (n < 2432) return 1798 + (n - 1792);
    if (n < 2438) return 1152 + (n - 2432);
    if (n >= 2440 && n < 2446) return 2438 + (n - 2440);
    return -1;
}
DI void conv_tile(const float* W, int N, int K, int k0, int n0, int srcbase, bf16_t* out, float* tile) {
    int tid_ = threadIdx.x; asm volatile("" : "+v"(tid_)); const int tid = tid_;
    for (int i = tid; i < 4096; i += 512) {
        const int kk = i >> 6, nn = i & 63; const int src = srcbase >= 0 ? srcbase + nn : map_in_col(n0 + nn);
        tile[nn * 65 + kk] = src >= 0 ? W[(size_t)(k0 + kk) * N + src] : 0.f;
    }
    __syncthreads();
    { const int nn = tid >> 3, kq = tid & 7; const float* t = tile + nn * 65 + kq * 8;
      u32x4 w = {pack2(t[0], t[1]), pack2(t[2], t[3]), pack2(t[4], t[5]), pack2(t[6], t[7])};
      *(u32x4*)(out + (size_t)(n0 + nn) * K + k0 + kq * 8) = w; }
    __syncthreads();
}
DI void phase0_weights(const PV& p, unsigned char* shm) {
    float* tile = (float*)shm;
    constexpr int PER = 640 + 256 + 1408 + 704 + 4;
    for (int it = blockIdx.x; it < DEPTH * PER; it += gridDim.x) {
        const int l = it / PER; int j = it - l * PER;
        if (j < 640) { conv_tile(p.w_in() + (size_t)l * 1024 * 2444, 2444, 1024, (j & 15) * 64, (j >> 4) * 64, -1, (bf16_t*)(p.ws() + WS_WIN + l * SZ_WIN), tile); continue; }
        j -= 640;
        if (j < 256) { conv_tile(p.w_out() + (size_t)l * 1024 * 1024, 1024, 1024, (j & 15) * 64, (j >> 4) * 64, (j >> 4) * 64, (bf16_t*)(p.ws() + WS_WOUT + l * SZ_WOUT), tile); continue; }
        j -= 256;
        if (j < 1408) { const int n0 = (j >> 4) * 64, t256 = n0 >> 8, within = n0 & 255;
            const float* src = (within < 128 ? p.w_gate() : p.w_up()) + (size_t)l * 1024 * DFF;
            conv_tile(src, DFF, 1024, (j & 15) * 64, n0, 128 * t256 + (within & 127), (bf16_t*)(p.ws() + WS_WGU + l * SZ_WGU), tile); continue; }
        j -= 1408;
        if (j < 704) { const int nt = j / 44, kt = j - nt * 44; conv_tile(p.w_down() + (size_t)l * DFF * 1024, 1024, DFF, kt * 64, nt * 64, nt * 64, (bf16_t*)(p.ws() + WS_WDN + l * SZ_WDN), tile); continue; }
        j -= 704;
        conv_tile(p.pool_w() + (size_t)(l * 4 + j) * 4096, 64, 64, 0, 0, 0, (bf16_t*)(p.ws() + WS_PWT) + (size_t)(l * 4 + j) * 4096, tile);
    }
}

DI void row_phase(const PV& p, int mode, const float* gpost, const float* gnext, bool final) {
    int tid_ = threadIdx.x; asm volatile("" : "+v"(tid_));
    const int lane = tid_ & 63, gw = blockIdx.x * 8 + (tid_ >> 6), nw = gridDim.x * 8;
    float* X = (float*)(p.ws() + WS_X); const float* OUTB = (const float*)(p.ws() + WS_OUT); bf16_t* H = (bf16_t*)(p.ws() + WS_H);
    for (int r = gw; r < MTOT; r += nw) {
        f32x4 x[4];
        int b = 0, t = 0; const bool isP = r < MP;
        if (isP) { b = r / TP; t = r - b * TP; }
        if (mode == 0) {
            const float* src;
            if (isP) src = t < NMETA ? p.meta() + (size_t)t * 1024 : p.x_prompt() + ((size_t)b * SEQ + (t - NMETA)) * 1024;
            else src = p.x_sample() + (size_t)(r - MP) * 1024;
#pragma unroll
            for (int j = 0; j < 4; ++j) x[j] = *(const f32x4*)(src + 4 * (lane + 64 * j));
        } else {
            f32x4 o[4]; float ss = 0.f;
#pragma unroll
            for (int j = 0; j < 4; ++j) { o[j] = *(const f32x4*)(OUTB + (size_t)r * 1024 + 4 * (lane + 64 * j)); ss += o[j][0] * o[j][0] + o[j][1] * o[j][1] + o[j][2] * o[j][2] + o[j][3] * o[j][3]; }
            ss = wave_sum(ss); const float rs = rsqrtf(ss * (1.f / 1024.f) + EPS);
#pragma unroll
            for (int j = 0; j < 4; ++j) { const f32x4 g = *(const f32x4*)(gpost + 4 * (lane + 64 * j)); const f32x4 xo = *(const f32x4*)(X + (size_t)r * 1024 + 4 * (lane + 64 * j)); x[j] = xo + o[j] * rs * g; }
        }
        if (final) {
            float* dst = nullptr;
            if (isP) { if (t >= NMETA) dst = p.out() + OFF_Y + ((size_t)b * SEQ + (t - NMETA)) * 1024; }
            else dst = p.out() + OFF_YS + (size_t)(r - MP) * 1024;
            if (dst) {
#pragma unroll
                for (int j = 0; j < 4; ++j) *(f32x4*)(dst + 4 * (lane + 64 * j)) = x[j];
            }
        } else {
            float ss = 0.f;
#pragma unroll
            for (int j = 0; j < 4; ++j) ss += x[j][0] * x[j][0] + x[j][1] * x[j][1] + x[j][2] * x[j][2] + x[j][3] * x[j][3];
            ss = wave_sum(ss); const float rs = rsqrtf(ss * (1.f / 1024.f) + EPS);
#pragma unroll
            for (int j = 0; j < 4; ++j) {
                *(f32x4*)(X + (size_t)r * 1024 + 4 * (lane + 64 * j)) = x[j];
                const f32x4 g = *(const f32x4*)(gnext + 4 * (lane + 64 * j)); const f32x4 hv = x[j] * rs * g;
                u32x2 w = {pack2(hv[0], hv[1]), pack2(hv[2], hv[3])}; *(u32x2*)(H + (size_t)r * 1024 + 4 * (lane + 64 * j)) = w;
            }
        }
    }
}

struct EpiF32 {
    static constexpr bool PERM = false, AFTER_DRAIN = false;
    float* C; int ldc;
    DI void operator()(const f32x4 (&acc)[2][2][4][2], const pg8::Unit& u, int wr, int wc, int fr, int fq) const {
        const int row0 = u.pm * 256 + wr * 64 + fr, col0 = u.pn * 256 + wc * 32 + 4 * fq;
#pragma unroll
        for (int ai = 0; ai < 2; ++ai)
#pragma unroll
            for (int m = 0; m < 4; ++m) { float* rowp = C + (size_t)(row0 + ai * 128 + m * 16) * ldc + col0;
#pragma unroll
                for (int bj = 0; bj < 2; ++bj)
#pragma unroll
                    for (int n = 0; n < 2; ++n) *(f32x4*)(rowp + bj * 128 + n * 16) = acc[ai][bj][m][n]; }
    }
};
struct EpiGU {
    static constexpr bool PERM = true, AFTER_DRAIN = false;
    bf16_t* O;
    DI void operator()(const f32x4 (&acc)[2][2][4][2], const pg8::Unit& u, int wr, int wc, int fr, int fq) const {
        const int row0 = u.pm * 256 + wr * 64 + fr, col0 = u.pn * 128 + wc * 32 + 8 * fq;
#pragma unroll
        for (int ai = 0; ai < 2; ++ai)
#pragma unroll
            for (int m = 0; m < 4; ++m) {
                const f32x4 g0 = acc[ai][0][m][0], g1 = acc[ai][0][m][1], u0 = acc[ai][1][m][0], u1 = acc[ai][1][m][1];
                u32x4 w = {pack2(siluf(g0[0]) * u0[0], siluf(g0[1]) * u0[1]), pack2(siluf(g0[2]) * u0[2], siluf(g0[3]) * u0[3]),
                           pack2(siluf(g1[0]) * u1[0], siluf(g1[1]) * u1[1]), pack2(siluf(g1[2]) * u1[2], siluf(g1[3]) * u1[3])};
                *(u32x4*)(O + (size_t)(row0 + ai * 128 + m * 16) * DFF + col0) = w;
            }
    }
};
DI float log_sigmoid(float x) { return fminf(x, 0.f) - log1pf(expf(-fabsf(x))); }
DI float softplusf(float x) { return fmaxf(x, 0.f) + log1pf(expf(-fabsf(x))); }
struct EpiIn {
    static constexpr bool PERM = true, AFTER_DRAIN = false;
    bf16_t* proj; bf16_t* vt; float* dtb; float* out; const float* fbias; const float* dtbias; int l;
    DI void operator()(const f32x4 (&acc)[2][2][4][2], const pg8::Unit& u, int wr, int wc, int fr, int fq) const {
#pragma unroll
        for (int ai = 0; ai < 2; ++ai)
#pragma unroll
            for (int m = 0; m < 4; ++m) {
                const int r = u.pm * 256 + ai * 128 + wr * 64 + m * 16 + fr;
                const bool valid = r < MTOT, isP = r < MP;
                int b, t; if (isP) { b = r / TP; t = r - b * TP; } else { const int rs = r - MP; b = rs >> 5; t = rs & 31; }
#pragma unroll
                for (int bj = 0; bj < 2; ++bj) {
                    const int cb = u.pn * 256 + bj * 128, c0 = cb + wc * 32 + fq * 8;
                    const f32x4 v0 = acc[ai][bj][m][0], v1 = acc[ai][bj][m][1];
                    if (cb < CF_) {
                        const float sc = cb < CK_ ? QSCALE : 1.f;
                        u32x4 w = {pack2(v0[0] * sc, v0[1] * sc), pack2(v0[2] * sc, v0[3] * sc), pack2(v1[0] * sc, v1[1] * sc), pack2(v1[2] * sc, v1[3] * sc)};
                        *(u32x4*)(proj + (size_t)r * NPROJ + c0) = w;
                        if (valid) {
                            if (cb >= CK_ && cb < CV_) {
                                float* d = out + (isP ? OFF_KP + ((size_t)l * MP + r) * 384 : OFF_KS + ((size_t)l * MS + (r - MP)) * 384) + (c0 - CK_);
                                *(f32x4*)d = v0; *(f32x4*)(d + 4) = v1;
                            } else if (cb >= CV_ && cb < CU_) {
                                float* d = out + (isP ? OFF_VP + ((size_t)l * MP + r) * 384 : OFF_VS + ((size_t)l * MS + (r - MP)) * 384) + (c0 - CV_);
                                *(f32x4*)d = v0; *(f32x4*)(d + 4) = v1;
                                if (isP) { const int cc = c0 - CV_, h = cc >> 6, d0 = cc & 63; bf16_t* vp = vt + ((size_t)(b * 6 + h) * 64 + d0) * 4160 + t;
                                    vp[0] = f2bf(v0[0]); vp[4160] = f2bf(v0[1]); vp[2 * 4160] = f2bf(v0[2]); vp[3 * 4160] = f2bf(v0[3]);
                                    vp[4 * 4160] = f2bf(v1[0]); vp[5 * 4160] = f2bf(v1[1]); vp[6 * 4160] = f2bf(v1[2]); vp[7 * 4160] = f2bf(v1[3]); }
                            } else if (cb >= CU_ && cb < CZ_) {
                                const int tt = isP ? t - (TP - 15) : t - (DS - 15);
                                if (tt >= 0) { float* d = out + (isP ? OFF_PP + (((size_t)l * NB + b) * 15 + tt) * 256 : OFF_PS + (((size_t)l * DB + b) * 15 + tt) * 256) + (c0 - CU_);
                                    *(f32x4*)d = v0; *(f32x4*)(d + 4) = v1; }
                            } else if (cb >= CX_) {
                                const int tt = isP ? t - (TP - 3) : t - (DS - 3);
                                if (tt >= 0) { float* d = out + (isP ? OFF_CP + (((size_t)l * NB + b) * 3 + tt) * 640 : OFF_CS + (((size_t)l * DB + b) * 3 + tt) * 640) + (c0 - CX_);
                                    *(f32x4*)d = v0; *(f32x4*)(d + 4) = v1; }
                            }
                        }
                    } else if (cb == CF_) {
                        if (valid && c0 == CF_) {
                            float* d = out + (isP ? OFF_LP + ((size_t)l * MP + r) * 6 : OFF_LS + ((size_t)l * MS + (r - MP)) * 6); const float* fb = fbias + l * 6;
                            d[0] = log_sigmoid(v0[0] + fb[0]); d[1] = log_sigmoid(v0[1] + fb[1]); d[2] = log_sigmoid(v0[2] + fb[2]); d[3] = log_sigmoid(v0[3] + fb[3]);
                            d[4] = log_sigmoid(v1[0] + fb[4]); d[5] = log_sigmoid(v1[1] + fb[5]);
                        }
                        if (c0 == CDT_) {
                            float* d = dtb + (size_t)r * 8; const float* db_ = dtbias + l * 6;
                            d[0] = softplusf(v0[0] + db_[0]); d[1] = softplusf(v0[1] + db_[1]); d[2] = softplusf(v0[2] + db_[2]); d[3] = softplusf(v0[3] + db_[3]);
                            d[4] = softplusf(v1[0] + db_[4]); d[5] = softplusf(v1[1] + db_[5]);
                        }
                    }
                }
            }
    }
};
constexpr int ABUF = 18688;
DI void attn_prompt(const PV& p, int l, int b, int h, int qi, unsigned char* shm) {
    int tid_ = threadIdx.x; asm volatile("" : "+v"(tid_)); const int tid = tid_, wid = tid >> 6, lane = tid & 63, col = lane & 31, hi = lane >> 5;
    const bf16_t* PROJ = (const bf16_t*)(p.ws() + WS_PROJ); const bf16_t* VT = (const bf16_t*)(p.ws() + WS_VT); bf16_t* MIX = (bf16_t*)(p.ws() + WS_MIX);
    const float* LOGF = p.out() + OFF_LP + (size_t)l * MP * 6;
    const int q0 = qi == 0 ? 0 : 16 + 256 * (qi - 1), nrows = qi == 0 ? 16 : 256, kend = q0 + nrows, nt = (kend + 63) >> 6;
    const int qw0 = q0 + 32 * wid; const bool wact = 32 * wid < nrows; const int qrow = qw0 + col;
    const size_t rowbase = (size_t)b * TP;
    bf16x8 qf[4];
    { const bf16_t* qp = PROJ + (rowbase + (qrow < TP ? qrow : TP - 1)) * NPROJ + h * 64 + 8 * hi;
#pragma unroll
      for (int ks = 0; ks < 4; ++ks) qf[ks] = *(const bf16x8*)(qp + 16 * ks); }
    const int lr = tid >> 3, lseg = tid & 7;
    const bf16_t* kg = PROJ + CK_ + h * 64 + lseg * 8;
    const bf16_t* vg = VT + ((size_t)(b * 6 + h) * 64 + lr) * 4160 + lseg * 8;
    float carry = 0.f; u32x4 kreg, vreg; float lfv = 0.f;
#define ATT_GLOAD(K0) do { const int key_ = (K0) + lr; kreg = *(const u32x4*)(kg + (rowbase + (key_ < TP ? key_ : TP - 1)) * NPROJ); vreg = *(const u32x4*)(vg + (K0)); \
        if (wid == 0) { const int kk_ = (K0) + lane; lfv = kk_ < TP ? LOGF[(rowbase + kk_) * 6 + h] : 0.f; } } while (0)
#define ATT_LSTORE(S) do { unsigned char* B_ = shm + (S) * ABUF; *(u32x4*)(B_ + lr * 144 + lseg * 16) = kreg; *(u32x4*)(B_ + 9216 + lr * 144 + lseg * 16) = vreg; \
        if (wid == 0) { float v_ = wave_scan_incl(lfv, lane) + carry; ((float*)(B_ + 18432))[lane] = -v_ * LOG2E; carry = __shfl(v_, 63); } } while (0)
    ATT_GLOAD(0); ATT_LSTORE(0); __syncthreads();
    f32x16 o0, o1;
#pragma unroll
    for (int i = 0; i < 16; ++i) { o0[i] = 0.f; o1[i] = 0.f; }
    float m = -1e30f, lsum = 0.f;
    for (int t = 0; t < nt; ++t) {
        const int k0 = t * 64; const bool more = t + 1 < nt;
        if (more) ATT_GLOAD(k0 + 64);
        if (wact && k0 <= qw0 + 31) {
            const unsigned char* B = shm + (t & 1) * ABUF;
            f32x16 s0, s1;
#pragma unroll
            for (int i = 0; i < 16; ++i) { s0[i] = 0.f; s1[i] = 0.f; }
#pragma unroll
            for (int ks = 0; ks < 4; ++ks) {
                const bf16x8 a0 = *(const bf16x8*)(B + col * 144 + (16 * ks + 8 * hi) * 2), a1 = *(const bf16x8*)(B + (32 + col) * 144 + (16 * ks + 8 * hi) * 2);
                s0 = MFMA32(a0, qf[ks], s0); s1 = MFMA32(a1, qf[ks], s1);
            }
            const float* cbp = (const float*)(B + 18432);
#pragma unroll
            for (int g = 0; g < 4; ++g) { const f32x4 c0 = *(const f32x4*)(cbp + 8 * g + 4 * hi), c1 = *(const f32x4*)(cbp + 32 + 8 * g + 4 * hi);
#pragma unroll
                for (int j = 0; j < 4; ++j) { s0[4 * g + j] += c0[j]; s1[4 * g + j] += c1[j]; } }
            if (k0 + 63 > qw0) {
#pragma unroll
                for (int i = 0; i < 16; ++i) { const int key = k0 + crow(i, hi); if (key > qrow) s0[i] = -INFINITY; if (key + 32 > qrow) s1[i] = -INFINITY; }
            }
            float mx = fmaxf(s0[0], s1[0]);
#pragma unroll
            for (int i = 1; i < 16; ++i) mx = fmaxf(mx, fmaxf(s0[i], s1[i]));
            mx = fmaxf(mx, __shfl_xor(mx, 32));
            const float mn = fmaxf(m, mx), alpha = ex2(m - mn); m = mn;
            float ps = 0.f;
#pragma unroll
            for (int i = 0; i < 16; ++i) { s0[i] = ex2(s0[i] - mn); s1[i] = ex2(s1[i] - mn); ps += s0[i] + s1[i]; }
            lsum = lsum * alpha + ps;
#pragma unroll
            for (int i = 0; i < 16; ++i) { o0[i] *= alpha; o1[i] *= alpha; }
#pragma unroll
            for (int kb = 0; kb < 2; ++kb)
#pragma unroll
                for (int s = 0; s < 2; ++s) {
                    const bf16x8 pf = kb == 0 ? pack8(s0[8 * s], s0[8 * s + 1], s0[8 * s + 2], s0[8 * s + 3], s0[8 * s + 4], s0[8 * s + 5], s0[8 * s + 6], s0[8 * s + 7])
                                              : pack8(s1[8 * s], s1[8 * s + 1], s1[8 * s + 2], s1[8 * s + 3], s1[8 * s + 4], s1[8 * s + 5], s1[8 * s + 6], s1[8 * s + 7]);
                    const unsigned char* vb = B + 9216 + (kb * 32 + 16 * s + 4 * hi) * 2;
                    const bf16x8 a0 = cat8(*(const u32x2*)(vb + col * 144), *(const u32x2*)(vb + col * 144 + 16));
                    const bf16x8 a1 = cat8(*(const u32x2*)(vb + (32 + col) * 144), *(const u32x2*)(vb + (32 + col) * 144 + 16));
                    o0 = MFMA32(a0, pf, o0); o1 = MFMA32(a1, pf, o1);
                }
        }
        if (more) ATT_LSTORE((t + 1) & 1);
        __syncthreads();
    }
#undef ATT_GLOAD
#undef ATT_LSTORE
    if (wact) {
        const float lt = lsum + __shfl_xor(lsum, 32); const float inv = 1.f / lt;
        if (qrow < kend) { bf16_t* op = MIX + (rowbase + qrow) * 1024 + h * 64;
#pragma unroll
            for (int g = 0; g < 4; ++g) {
                u32x2 w0 = {pack2(o0[4 * g] * inv, o0[4 * g + 1] * inv), pack2(o0[4 * g + 2] * inv, o0[4 * g + 3] * inv)};
                u32x2 w1 = {pack2(o1[4 * g] * inv, o1[4 * g + 1] * inv), pack2(o1[4 * g + 2] * inv, o1[4 * g + 3] * inv)};
                *(u32x2*)(op + 8 * g + 4 * hi) = w0; *(u32x2*)(op + 32 + 8 * g + 4 * hi) = w1;
            } }
    }
}

DI void attn_sample(const PV& p, int l, int b, int h, unsigned char* shm) {
    int tid_ = threadIdx.x; asm volatile("" : "+v"(tid_)); const int tid = tid_, wid = tid >> 6, lane = tid & 63, col = lane & 31, hi = lane >> 5;
    const bf16_t* PROJ = (const bf16_t*)(p.ws() + WS_PROJ); bf16_t* MIX = (bf16_t*)(p.ws() + WS_MIX);
    float* cbs = (float*)shm; float* OW = (float*)(shm + 4352); float* ML = (float*)(shm + 4352 + 65536);
    const size_t cbase = (size_t)(l * DB + b) * PAST; const size_t rbase = (size_t)MP + b * 32;
    if (wid == 0) {
        const float* cl = p.cache_logf() + cbase * 6 + h; const float* lfn = p.out() + OFF_LS + ((size_t)l * MS + b * 32) * 6 + h;
        float v[17];
#pragma unroll
        for (int i = 0; i < 17; ++i) { const int idx = i * 64 + lane; v[i] = idx < PAST ? cl[(size_t)idx * 6] : (idx < PAST + DS ? lfn[(size_t)(idx - PAST) * 6] : 0.f); }
        float carry = 0.f;
#pragma unroll
        for (int i = 0; i < 17; ++i) { const int idx = i * 64 + lane; const float s = wave_scan_incl(v[i], lane) + carry; if (idx < PAST + DS) cbs[idx] = -s * LOG2E; carry = __shfl(s, 63); }
    }
    __syncthreads();
    bf16x8 qf[4];
    { const bf16_t* qp = PROJ + (rbase + col) * NPROJ + h * 64 + 8 * hi;
#pragma unroll
      for (int ks = 0; ks < 4; ++ks) qf[ks] = *(const bf16x8*)(qp + 16 * ks); }
    f32x16 o0, o1;
#pragma unroll
    for (int i = 0; i < 16; ++i) { o0[i] = 0.f; o1[i] = 0.f; }
    float m = -1e30f, lsum = 0.f;
    for (int tile = wid; tile < 33; tile += 8) {
        f32x16 s;
#pragma unroll
        for (int i = 0; i < 16; ++i) s[i] = 0.f;
        if (tile < 32) {
            const float* kp = p.cache_k() + (cbase + tile * 32 + col) * 384 + h * 64 + 8 * hi;
#pragma unroll
            for (int ks = 0; ks < 4; ++ks) { const f32x4 x0 = *(const f32x4*)(kp + 16 * ks), x1 = *(const f32x4*)(kp + 16 * ks + 4);
                s = MFMA32(pack8(x0[0], x0[1], x0[2], x0[3], x1[0], x1[1], x1[2], x1[3]), qf[ks], s); }
        } else {
            const bf16_t* kp = PROJ + (rbase + col) * NPROJ + CK_ + h * 64 + 8 * hi;
#pragma unroll
            for (int ks = 0; ks < 4; ++ks) s = MFMA32(*(const bf16x8*)(kp + 16 * ks), qf[ks], s);
        }
#pragma unroll
        for (int g = 0; g < 4; ++g) { const f32x4 c0 = *(const f32x4*)(cbs + tile * 32 + 8 * g + 4 * hi);
#pragma unroll
            for (int j = 0; j < 4; ++j) s[4 * g + j] += c0[j]; }
        if (tile == 32) {
#pragma unroll
            for (int i = 0; i < 16; ++i) if (crow(i, hi) > col) s[i] = -INFINITY;
        }
        float mx = s[0];
#pragma unroll
        for (int i = 1; i < 16; ++i) mx = fmaxf(mx, s[i]);
        mx = fmaxf(mx, __shfl_xor(mx, 32));
        const float mn = fmaxf(m, mx), alpha = ex2(m - mn); m = mn;
        float ps = 0.f;
#pragma unroll
        for (int i = 0; i < 16; ++i) { s[i] = ex2(s[i] - mn); ps += s[i]; }
        lsum = lsum * alpha + ps;
#pragma unroll
        for (int i = 0; i < 16; ++i) { o0[i] *= alpha; o1[i] *= alpha; }
#pragma unroll
        for (int ss = 0; ss < 2; ++ss) {
            const bf16x8 pf = pack8(s[8 * ss], s[8 * ss + 1], s[8 * ss + 2], s[8 * ss + 3], s[8 * ss + 4], s[8 * ss + 5], s[8 * ss + 6], s[8 * ss + 7]);
            bf16x8 a0, a1;
            if (tile < 32) {
                const float* vp = p.cache_v() + (cbase + tile * 32 + 16 * ss + 4 * hi) * 384 + h * 64 + col;
                a0 = pack8(vp[0], vp[384], vp[2 * 384], vp[3 * 384], vp[8 * 384], vp[9 * 384], vp[10 * 384], vp[11 * 384]);
                a1 = pack8(vp[32], vp[384 + 32], vp[2 * 384 + 32], vp[3 * 384 + 32], vp[8 * 384 + 32], vp[9 * 384 + 32], vp[10 * 384 + 32], vp[11 * 384 + 32]);
            } else {
                const bf16_t* vp = PROJ + (rbase + 16 * ss + 4 * hi) * NPROJ + CV_ + h * 64 + col;
                u32x4 w0 = {(unsigned)vp[0] | ((unsigned)vp[NPROJ] << 16), (unsigned)vp[2 * NPROJ] | ((unsigned)vp[3 * NPROJ] << 16),
                            (unsigned)vp[8 * NPROJ] | ((unsigned)vp[9 * NPROJ] << 16), (unsigned)vp[10 * NPROJ] | ((unsigned)vp[11 * NPROJ] << 16)};
                u32x4 w1 = {(unsigned)vp[32] | ((unsigned)vp[NPROJ + 32] << 16), (unsigned)vp[2 * NPROJ + 32] | ((unsigned)vp[3 * NPROJ + 32] << 16),
                            (unsigned)vp[8 * NPROJ + 32] | ((unsigned)vp[9 * NPROJ + 32] << 16), (unsigned)vp[10 * NPROJ + 32] | ((unsigned)vp[11 * NPROJ + 32] << 16)};
                a0 = __builtin_bit_cast(bf16x8, w0); a1 = __builtin_bit_cast(bf16x8, w1);
            }
            o0 = MFMA32(a0, pf, o0); o1 = MFMA32(a1, pf, o1);
        }
    }
    { const float lt = lsum + __shfl_xor(lsum, 32); float* Ow = OW + wid * 2048;
#pragma unroll
      for (int i = 0; i < 16; ++i) { Ow[crow(i, hi) * 32 + col] = o0[i]; Ow[(32 + crow(i, hi)) * 32 + col] = o1[i]; }
      if (hi == 0) { ML[(wid * 32 + col) * 2] = m; ML[(wid * 32 + col) * 2 + 1] = lt; } }
    __syncthreads();
    { const int q = tid & 31, dg = tid >> 5; float M = -1e30f;
#pragma unroll
      for (int w = 0; w < 8; ++w) M = fmaxf(M, ML[(w * 32 + q) * 2]);
      float L = 0.f, a0 = 0.f, a1 = 0.f, a2 = 0.f, a3 = 0.f;
#pragma unroll
      for (int w = 0; w < 8; ++w) { const float f = ex2(ML[(w * 32 + q) * 2] - M); L += ML[(w * 32 + q) * 2 + 1] * f; const float* Ow = OW + w * 2048 + (4 * dg) * 32 + q;
          a0 += Ow[0] * f; a1 += Ow[32] * f; a2 += Ow[64] * f; a3 += Ow[96] * f; }
      const float inv = 1.f / L; u32x2 w = {pack2(a0 * inv, a1 * inv), pack2(a2 * inv, a3 * inv)};
      *(u32x2*)(MIX + (rbase + q) * 1024 + h * 64 + 4 * dg) = w; }
}

constexpr int L_XT = 0, L_BM = 55296, L_BT = 73728, L_CM = 92160, L_DTS = 110592, L_ACS = 112128;
DI void ssd_a(const PV& p, int l, int grp, int b, int c, unsigned char* shm) {
    int tid_ = threadIdx.x; asm volatile("" : "+v"(tid_)); const int tid = tid_, wid = tid >> 6, lane = tid & 63, col = lane & 31, hi = lane >> 5;
    const bf16_t* PROJ = (const bf16_t*)(p.ws() + WS_PROJ); const float* DT = (const float*)(p.ws() + WS_DT);
    float* Y32 = (float*)(p.ws() + WS_Y32); bf16_t* CC = (bf16_t*)(p.ws() + WS_CC); float* ACSG = (float*)(p.ws() + WS_ACS); float* ST = (float*)(p.ws() + WS_ST);
    bf16_t* XT = (bf16_t*)(shm + L_XT); bf16_t* BM = (bf16_t*)(shm + L_BM); bf16_t* BT = (bf16_t*)(shm + L_BT); bf16_t* CM = (bf16_t*)(shm + L_CM);
    float* DTS = (float*)(shm + L_DTS); float* ACSL = (float*)(shm + L_ACS);
    const int t0 = grp == 0 ? 64 * c - 48 : 0, tlim = grp == 0 ? TP : DS;
    const size_t rbase = grp == 0 ? (size_t)b * TP : (size_t)MP + b * 32;
    if (wid < 6) {
        const int t = t0 + lane; const bool valid = t >= 0 && t < tlim;
        const float dt = valid ? DT[(rbase + t) * 8 + wid] : 0.f; const float a = -expf(p.a_log()[l * 6 + wid]);
        const float acs = wave_scan_incl(dt * a, lane);
        DTS[wid * 64 + lane] = dt; ACSL[wid * 64 + lane] = acs; if (valid) ACSG[(rbase + t) * 8 + wid] = acs;
    }
    const float* cw = p.conv_w() + (size_t)l * 4 * 640; const float* cbias = p.conv_b() + (size_t)l * 640;
    for (int idx = tid; idx < 64 * 160; idx += 512) {
        const int s = idx / 160, ch = 4 * (idx - s * 160); const int t = t0 + s; const bool valid = t >= 0 && t < tlim;
        f32x4 a = *(const f32x4*)(cbias + ch);
#pragma unroll
        for (int j = 0; j < 4; ++j) {
            const int tt = t + j - 3; f32x4 x = {0.f, 0.f, 0.f, 0.f};
            if (tt >= 0) { if (tt < tlim) { const u32x2 w = *(const u32x2*)(PROJ + (rbase + tt) * NPROJ + CX_ + ch); x = (f32x4){bf_lo(w.x), bf_hi(w.x), bf_lo(w.y), bf_hi(w.y)}; } }
            else if (grp == 1) x = *(const f32x4*)(p.state_conv() + ((size_t)(l * DB + b) * 3 + 3 + tt) * 640 + ch);
            a += x * *(const f32x4*)(cw + j * 640 + ch);
        }
        f32x4 v = {siluf(a[0]), siluf(a[1]), siluf(a[2]), siluf(a[3])};
        if (!valid) v = (f32x4){0.f, 0.f, 0.f, 0.f};
        if (ch < 384) { const int hh = ch >> 6, pp = ch & 63; bf16_t* d = XT + ((hh * 64 + pp) * 72 + s);
            d[0] = f2bf(v[0]); d[72] = f2bf(v[1]); d[144] = f2bf(v[2]); d[216] = f2bf(v[3]); }
        else if (ch < 512) { const int g = (ch - 384) >> 6, n = (ch - 384) & 63; u32x2 w = {pack2(v[0], v[1]), pack2(v[2], v[3])};
            *(u32x2*)(BM + (g * 64 + s) * 72 + n) = w; bf16_t* d = BT + ((g * 64 + n) * 72 + s);
            d[0] = (bf16_t)(w.x & 0xffffu); d[72] = (bf16_t)(w.x >> 16); d[144] = (bf16_t)(w.y & 0xffffu); d[216] = (bf16_t)(w.y >> 16); }
        else { const int g = (ch - 512) >> 6, n = (ch - 512) & 63; u32x2 w = {pack2(v[0], v[1]), pack2(v[2], v[3])};
            *(u32x2*)(CM + (g * 64 + s) * 72 + n) = w; if (valid) *(u32x2*)(CC + (rbase + t) * 128 + (ch - 512)) = w; }
    }
    __syncthreads();
    if (wid < 6) {
        const int h = wid, g = h / 3; const float Dh = p.d_skip()[l * 6 + h];
        const float* acsl = ACSL + h * 64; const float* dts = DTS + h * 64;
        const float acsq0 = acsl[col], acsq1 = acsl[32 + col], acs63 = acsl[63];
        const bf16_t* xt = XT + h * 64 * 72; const bf16_t* bm = BM + g * 64 * 72; const bf16_t* bt = BT + g * 64 * 72; const bf16_t* cm = CM + g * 64 * 72;
        f32x16 g00, g01, g11;
#pragma unroll
        for (int i = 0; i < 16; ++i) { g00[i] = 0.f; g01[i] = 0.f; g11[i] = 0.f; }
#pragma unroll
        for (int ks = 0; ks < 4; ++ks) {
            const int ko = 16 * ks + 8 * hi;
            const bf16x8 bs0 = *(const bf16x8*)(bm + col * 72 + ko), bs1 = *(const bf16x8*)(bm + (32 + col) * 72 + ko);
            const bf16x8 cq0 = *(const bf16x8*)(cm + col * 72 + ko), cq1 = *(const bf16x8*)(cm + (32 + col) * 72 + ko);
            g00 = MFMA32(bs0, cq0, g00); g01 = MFMA32(bs0, cq1, g01); g11 = MFMA32(bs1, cq1, g11);
        }
#pragma unroll
        for (int gq = 0; gq < 4; ++gq) {
            const f32x4 as0 = *(const f32x4*)(acsl + 8 * gq + 4 * hi), as1 = *(const f32x4*)(acsl + 32 + 8 * gq + 4 * hi);
            const f32x4 ds0 = *(const f32x4*)(dts + 8 * gq + 4 * hi), ds1 = *(const f32x4*)(dts + 32 + 8 * gq + 4 * hi);
#pragma unroll
            for (int j = 0; j < 4; ++j) { const int i = 4 * gq + j, s = 8 * gq + 4 * hi + j;
                g00[i] = s <= col ? g00[i] * __expf(acsq0 - as0[j]) * ds0[j] + (s == col ? Dh : 0.f) : 0.f;
                g01[i] = g01[i] * __expf(acsq1 - as0[j]) * ds0[j];
                g11[i] = s <= col ? g11[i] * __expf(acsq1 - as1[j]) * ds1[j] + (s == col ? Dh : 0.f) : 0.f; }
        }
        f32x16 y00, y10, y01, y11;
#pragma unroll
        for (int i = 0; i < 16; ++i) { y00[i] = 0.f; y10[i] = 0.f; y01[i] = 0.f; y11[i] = 0.f; }
#pragma unroll
        for (int ss = 0; ss < 2; ++ss) {
            const int so = 16 * ss + 4 * hi;
            const bf16x8 xa0 = cat8(*(const u32x2*)(xt + col * 72 + so), *(const u32x2*)(xt + col * 72 + so + 8));
            const bf16x8 xa1 = cat8(*(const u32x2*)(xt + (32 + col) * 72 + so), *(const u32x2*)(xt + (32 + col) * 72 + so + 8));
            const bf16x8 xb0 = cat8(*(const u32x2*)(xt + col * 72 + 32 + so), *(const u32x2*)(xt + col * 72 + 32 + so + 8));
            const bf16x8 xb1 = cat8(*(const u32x2*)(xt + (32 + col) * 72 + 32 + so), *(const u32x2*)(xt + (32 + col) * 72 + 32 + so + 8));
            const bf16x8 p00 = pack8(g00[8 * ss], g00[8 * ss + 1], g00[8 * ss + 2], g00[8 * ss + 3], g00[8 * ss + 4], g00[8 * ss + 5], g00[8 * ss + 6], g00[8 * ss + 7]);
            const bf16x8 p01 = pack8(g01[8 * ss], g01[8 * ss + 1], g01[8 * ss + 2], g01[8 * ss + 3], g01[8 * ss + 4], g01[8 * ss + 5], g01[8 * ss + 6], g01[8 * ss + 7]);
            const bf16x8 p11 = pack8(g11[8 * ss], g11[8 * ss + 1], g11[8 * ss + 2], g11[8 * ss + 3], g11[8 * ss + 4], g11[8 * ss + 5], g11[8 * ss + 6], g11[8 * ss + 7]);
            y00 = MFMA32(xa0, p00, y00); y10 = MFMA32(xa1, p00, y10);
            y01 = MFMA32(xa0, p01, y01); y11 = MFMA32(xa1, p01, y11);
            y01 = MFMA32(xb0, p11, y01); y11 = MFMA32(xb1, p11, y11);
        }
        {
            const int tq0 = t0 + col, tq1 = t0 + 32 + col;
            if (tq0 >= 0 && tq0 < tlim) { float* yp = Y32 + (rbase + tq0) * 384 + h * 64;
#pragma unroll
                for (int gq = 0; gq < 4; ++gq) { *(f32x4*)(yp + 8 * gq + 4 * hi) = (f32x4){y00[4 * gq], y00[4 * gq + 1], y00[4 * gq + 2], y00[4 * gq + 3]};
                    *(f32x4*)(yp + 32 + 8 * gq + 4 * hi) = (f32x4){y10[4 * gq], y10[4 * gq + 1], y10[4 * gq + 2], y10[4 * gq + 3]}; } }
            if (tq1 >= 0 && tq1 < tlim) { float* yp = Y32 + (rbase + tq1) * 384 + h * 64;
#pragma unroll
                for (int gq = 0; gq < 4; ++gq) { *(f32x4*)(yp + 8 * gq + 4 * hi) = (f32x4){y01[4 * gq], y01[4 * gq + 1], y01[4 * gq + 2], y01[4 * gq + 3]};
                    *(f32x4*)(yp + 32 + 8 * gq + 4 * hi) = (f32x4){y11[4 * gq], y11[4 * gq + 1], y11[4 * gq + 2], y11[4 * gq + 3]}; } }
        }
        f32x16 c00, c01, c10, c11;
#pragma unroll
        for (int i = 0; i < 16; ++i) { c00[i] = 0.f; c01[i] = 0.f; c10[i] = 0.f; c11[i] = 0.f; }
#pragma unroll
        for (int ks = 0; ks < 4; ++ks) {
            const int ko = 16 * ks + 8 * hi;
            const bf16x8 xa0 = *(const bf16x8*)(xt + col * 72 + ko), xa1 = *(const bf16x8*)(xt + (32 + col) * 72 + ko);
            const f32x4 wa = *(const f32x4*)(acsl + ko), wb = *(const f32x4*)(acsl + ko + 4), da = *(const f32x4*)(dts + ko), db_ = *(const f32x4*)(dts + ko + 4);
            float w3[8];
#pragma unroll
            for (int j = 0; j < 4; ++j) { w3[j] = da[j] * __expf(acs63 - wa[j]); w3[4 + j] = db_[j] * __expf(acs63 - wb[j]); }
            const u32x4 r0 = *(const u32x4*)(bt + col * 72 + ko), r1 = *(const u32x4*)(bt + (32 + col) * 72 + ko);
            const bf16x8 b0 = pack8(bf_lo(r0.x) * w3[0], bf_hi(r0.x) * w3[1], bf_lo(r0.y) * w3[2], bf_hi(r0.y) * w3[3], bf_lo(r0.z) * w3[4], bf_hi(r0.z) * w3[5], bf_lo(r0.w) * w3[6], bf_hi(r0.w) * w3[7]);
            const bf16x8 b1 = pack8(bf_lo(r1.x) * w3[0], bf_hi(r1.x) * w3[1], bf_lo(r1.y) * w3[2], bf_hi(r1.y) * w3[3], bf_lo(r1.z) * w3[4], bf_hi(r1.z) * w3[5], bf_lo(r1.w) * w3[6], bf_hi(r1.w) * w3[7]);
            c00 = MFMA32(xa0, b0, c00); c01 = MFMA32(xa0, b1, c01); c10 = MFMA32(xa1, b0, c10); c11 = MFMA32(xa1, b1, c11);
        }
        if (grp == 0) { float* sp = ST + ((size_t)(b * NCH + c) * 6 + h) * 4096;
#pragma unroll
            for (int i = 0; i < 16; ++i) { const int pr = crow(i, hi); sp[pr * 64 + col] = c00[i]; sp[pr * 64 + 32 + col] = c01[i]; sp[(32 + pr) * 64 + col] = c10[i]; sp[(32 + pr) * 64 + 32 + col] = c11[i]; } }
        else { const size_t so = ((size_t)(l * DB + b) * 6 + h) * 4096; const float* ip = p.state_ssd() + so; float* op = p.out() + OFF_SS + so; const float dec = __expf(acs63);
#pragma unroll
            for (int i = 0; i < 16; ++i) { const int pr = crow(i, hi);
                op[pr * 64 + col] = dec * ip[pr * 64 + col] + c00[i]; op[pr * 64 + 32 + col] = dec * ip[pr * 64 + 32 + col] + c01[i];
                op[(32 + pr) * 64 + col] = dec * ip[(32 + pr) * 64 + col] + c10[i]; op[(32 + pr) * 64 + 32 + col] = dec * ip[(32 + pr) * 64 + 32 + col] + c11[i]; } }
    }
}

DI void ssd_scan(const PV& p, int l) {
    float* ST = (float*)(p.ws() + WS_ST); const float* ACSG = (const float*)(p.ws() + WS_ACS);
    int tid_ = threadIdx.x; asm volatile("" : "+v"(tid_));
    for (int e = blockIdx.x * 512 + tid_; e < NB * 6 * 4096; e += gridDim.x * 512) {
        const int bh = e >> 12, pn = e & 4095, b = bh / 6, h = bh - b * 6;
        float state = 0.f;
        for (int c0 = 0; c0 < NCH; c0 += 13) {
            float cs[13], dec[13];
#pragma unroll
            for (int j = 0; j < 13; ++j) { cs[j] = ST[((size_t)(b * NCH + c0 + j) * 6 + h) * 4096 + pn]; dec[j] = __expf(ACSG[((size_t)b * TP + 64 * (c0 + j) + 15) * 8 + h]); }
#pragma unroll
            for (int j = 0; j < 13; ++j) { ST[((size_t)(b * NCH + c0 + j) * 6 + h) * 4096 + pn] = state; state = dec[j] * state + cs[j]; }
        }
        p.out()[OFF_SP + ((size_t)(l * NB + b) * 6 + h) * 4096 + pn] = state;
    }
}

DI void ssd_c(const PV& p, int l, int grp, int b, int c, unsigned char* shm) {
    int tid_ = threadIdx.x; asm volatile("" : "+v"(tid_)); const int tid = tid_, wid = tid >> 6, lane = tid & 63, col = lane & 31, hi = lane >> 5;
    const bf16_t* PROJ = (const bf16_t*)(p.ws() + WS_PROJ); const float* Y32 = (const float*)(p.ws() + WS_Y32); const bf16_t* CC = (const bf16_t*)(p.ws() + WS_CC);
    const float* ACSG = (const float*)(p.ws() + WS_ACS); const float* ST = (const float*)(p.ws() + WS_ST); bf16_t* MIX = (bf16_t*)(p.ws() + WS_MIX);
    float* SSQ = (float*)shm;
    const int t0 = grp == 0 ? 64 * c - 48 : 0, tlim = grp == 0 ? TP : DS;
    const size_t rbase = grp == 0 ? (size_t)b * TP : (size_t)MP + b * 32;
    f32x16 y[2][2];
    const int h = wid, g = h / 3;
    int tq[2]; bool vq[2]; size_t rq[2];
#pragma unroll
    for (int qb = 0; qb < 2; ++qb) { const int t = t0 + 32 * qb + col; vq[qb] = t >= 0 && t < tlim; tq[qb] = t < 0 ? 0 : (t >= tlim ? tlim - 1 : t); rq[qb] = rbase + tq[qb]; }
    if (wid < 6) {
        const float* prev = grp == 0 ? ST + ((size_t)(b * NCH + c) * 6 + h) * 4096 : p.state_ssd() + ((size_t)(l * DB + b) * 6 + h) * 4096;
#pragma unroll
        for (int pb = 0; pb < 2; ++pb)
#pragma unroll
            for (int qb = 0; qb < 2; ++qb)
#pragma unroll
                for (int i = 0; i < 16; ++i) y[pb][qb][i] = 0.f;
#pragma unroll
        for (int ks = 0; ks < 4; ++ks) {
            const int ko = 16 * ks + 8 * hi;
            bf16x8 a[2], bq[2];
#pragma unroll
            for (int pb = 0; pb < 2; ++pb) { const float* pp = prev + (32 * pb + col) * 64 + ko; const f32x4 x0 = *(const f32x4*)pp, x1 = *(const f32x4*)(pp + 4);
                a[pb] = pack8(x0[0], x0[1], x0[2], x0[3], x1[0], x1[1], x1[2], x1[3]); }
#pragma unroll
            for (int qb = 0; qb < 2; ++qb) bq[qb] = *(const bf16x8*)(CC + rq[qb] * 128 + g * 64 + ko);
#pragma unroll
            for (int pb = 0; pb < 2; ++pb)
#pragma unroll
                for (int qb = 0; qb < 2; ++qb) y[pb][qb] = MFMA32(a[pb], bq[qb], y[pb][qb]);
        }
#pragma unroll
        for (int qb = 0; qb < 2; ++qb) {
            const float eq = __expf(ACSG[rq[qb] * 8 + h]); float ssq = 0.f;
#pragma unroll
            for (int pb = 0; pb < 2; ++pb)
#pragma unroll
                for (int gq = 0; gq < 4; ++gq) {
                    const int p0 = 32 * pb + 8 * gq + 4 * hi;
                    const f32x4 yd = *(const f32x4*)(Y32 + rq[qb] * 384 + h * 64 + p0); const u32x2 zw = *(const u32x2*)(PROJ + rq[qb] * NPROJ + CZ_ + h * 64 + p0);
                    const float z0 = bf_lo(zw.x), z1 = bf_hi(zw.x), z2 = bf_lo(zw.y), z3 = bf_hi(zw.y);
                    const float v0 = (yd[0] + eq * y[pb][qb][4 * gq]) * siluf(z0), v1 = (yd[1] + eq * y[pb][qb][4 * gq + 1]) * siluf(z1);
                    const float v2 = (yd[2] + eq * y[pb][qb][4 * gq + 2]) * siluf(z2), v3 = (yd[3] + eq * y[pb][qb][4 * gq + 3]) * siluf(z3);
                    y[pb][qb][4 * gq] = v0; y[pb][qb][4 * gq + 1] = v1; y[pb][qb][4 * gq + 2] = v2; y[pb][qb][4 * gq + 3] = v3;
                    ssq += v0 * v0 + v1 * v1 + v2 * v2 + v3 * v3;
                }
            ssq += __shfl_xor(ssq, 32);
            if (hi == 0) SSQ[h * 64 + 32 * qb + col] = ssq;
        }
    }
    __syncthreads();
    if (wid < 6) {
        const float* gn = p.ssd_norm() + (size_t)l * 384 + h * 64;
#pragma unroll
        for (int qb = 0; qb < 2; ++qb) {
            float tot = 0.f;
#pragma unroll
            for (int hh = 0; hh < 6; ++hh) tot += SSQ[hh * 64 + 32 * qb + col];
            const float rs = rsqrtf(tot * (1.f / 384.f) + EPS);
            if (vq[qb]) {
#pragma unroll
                for (int pb = 0; pb < 2; ++pb)
#pragma unroll
                    for (int gq = 0; gq < 4; ++gq) {
                        const int p0 = 32 * pb + 8 * gq + 4 * hi; const f32x4 gg = *(const f32x4*)(gn + p0);
                        u32x2 w = {pack2(y[pb][qb][4 * gq] * rs * gg[0], y[pb][qb][4 * gq + 1] * rs * gg[1]), pack2(y[pb][qb][4 * gq + 2] * rs * gg[2], y[pb][qb][4 * gq + 3] * rs * gg[3])};
                        *(u32x2*)(MIX + rq[qb] * 1024 + 640 + h * 64 + p0) = w;
                    }
            }
        }
    }
}

DI void pool_item(const PV& p, int l, int grp, int b, int j, unsigned char* shm) {
    int tid_ = threadIdx.x; asm volatile("" : "+v"(tid_)); const int tid = tid_, wid = tid >> 6, lane = tid & 63, col = lane & 31, hi = lane >> 5;
    const bf16_t* PROJ = (const bf16_t*)(p.ws() + WS_PROJ); bf16_t* MIX = (bf16_t*)(p.ws() + WS_MIX); const bf16_t* PWT = (const bf16_t*)(p.ws() + WS_PWT);
    float* EXT = (float*)shm; bf16_t* D = (bf16_t*)(shm + 80896);
    const int t0 = 64 * j, tlim = grp == 0 ? TP : DS; const size_t rbase = grp == 0 ? (size_t)b * TP : (size_t)MP + b * 32;
    for (int idx = tid; idx < 79 * 64; idx += 512) {
        const int e = idx >> 6, ch = 4 * (idx & 63); const int t = t0 - 15 + e; f32x4 x = {0.f, 0.f, 0.f, 0.f};
        if (t >= 0) { if (t < tlim) { const u32x2 w = *(const u32x2*)(PROJ + (rbase + t) * NPROJ + CU_ + ch); x = (f32x4){bf_lo(w.x), bf_hi(w.x), bf_lo(w.y), bf_hi(w.y)}; } }
        else if (grp == 1) x = *(const f32x4*)(p.state_pool() + ((size_t)(l * DB + b) * 15 + 15 + t) * 256 + ch);
        *(f32x4*)(EXT + e * 256 + ch) = x;
    }
    __syncthreads();
    { const int ch = tid & 255, half = tid >> 8, g = ch >> 6, w = 2 << g;
      for (int s = half * 32; s < half * 32 + 32; ++s) {
          float sum = 0.f; for (int k = 0; k < w; ++k) sum += EXT[(s + 15 - k) * 256 + ch];
          const int t = t0 + s; const int cnt = grp == 0 ? (t + 1 < w ? t + 1 : w) : w;
          D[s * 264 + ch] = f2bf(sum / (float)cnt - EXT[(s + 15) * 256 + ch]);
      } }
    __syncthreads();
    { const int g = wid >> 1, sb = wid & 1; f32x16 y0, y1;
#pragma unroll
      for (int i = 0; i < 16; ++i) { y0[i] = 0.f; y1[i] = 0.f; }
      const bf16_t* wp = PWT + (size_t)(l * 4 + g) * 4096;
#pragma unroll
      for (int ks = 0; ks < 4; ++ks) {
          const int ko = 16 * ks + 8 * hi;
          const bf16x8 a0 = *(const bf16x8*)(wp + col * 64 + ko), a1 = *(const bf16x8*)(wp + (32 + col) * 64 + ko);
          const bf16x8 bq = *(const bf16x8*)(D + (32 * sb + col) * 264 + g * 64 + ko);
          y0 = MFMA32(a0, bq, y0); y1 = MFMA32(a1, bq, y1);
      }
      const int t = t0 + 32 * sb + col;
      if (t < tlim) { bf16_t* op = MIX + (rbase + t) * 1024 + 384 + g * 64; const float* sc = p.pool_scale() + (size_t)l * 256 + g * 64;
#pragma unroll
          for (int gq = 0; gq < 4; ++gq) { const int e0 = 8 * gq + 4 * hi; const f32x4 s0 = *(const f32x4*)(sc + e0), s1 = *(const f32x4*)(sc + 32 + e0);
              u32x2 w0 = {pack2(y0[4 * gq] * s0[0], y0[4 * gq + 1] * s0[1]), pack2(y0[4 * gq + 2] * s0[2], y0[4 * gq + 3] * s0[3])};
              u32x2 w1 = {pack2(y1[4 * gq] * s1[0], y1[4 * gq + 1] * s1[1]), pack2(y1[4 * gq + 2] * s1[2], y1[4 * gq + 3] * s1[3])};
              *(u32x2*)(op + e0) = w0; *(u32x2*)(op + 32 + e0) = w1; } }
    }
}
#ifndef PHMASK
#define PHMASK 8191
#endif
DI int next_item(unsigned* ctr, int* slot) { __syncthreads(); if (threadIdx.x == 0) *slot = (int)atomicAdd(ctr, 1u); __syncthreads(); return *slot; }
constexpr int N_ATT_P = 24 * 17, N_ATT_S = DB * 6, N_SSD = NB * NCH + DB, N_POOL = NB * NCH + DB, N_P2 = N_ATT_P + N_ATT_S + N_SSD + N_POOL;
constexpr size_t LDS_BYTES = 131072 + 1024;

__global__ void __launch_bounds__(512, 2) hymba_fwd(Params params) {
    const PV p{};
    extern __shared__ __attribute__((aligned(16))) unsigned char shm[];
    cg::grid_group grid = cg::this_grid();
    int* slot = (int*)(shm + 131072);
    PG8_LAS unsigned char* lds = (PG8_LAS unsigned char*)shm;


    for (int ph = 0; ph < 1 + 9 * DEPTH; ++ph) {
        const int l = ph == 0 ? 0 : (ph - 1) / 9, k = ph == 0 ? -1 : (ph - 1) % 9;
        switch (k) {
        case -1:
#if PHMASK & 1
 phase0_weights(p, shm); row_phase(p, 0, nullptr, p.ln_pre_mix(), false);
#endif
 break;
        case 0: {
            pg8::Gemm g{(const bf16_t*)(p.ws() + WS_H), (const bf16_t*)(p.ws() + WS_WIN + l * SZ_WIN), MPAD, NPROJ, 1024};
            pg8::StaticOrder S; S.init(MPAD, NPROJ, (int)gridDim.x, (int)blockIdx.x);
            EpiIn E{(bf16_t*)(p.ws() + WS_PROJ), (bf16_t*)(p.ws() + WS_VT), (float*)(p.ws() + WS_DT), p.out(), p.fox_f_bias(), p.dt_bias(), l};
#if PHMASK & 2
            pg8::gemm_phase<EpiIn, pg8::StaticOrder, false>(lds, g, S, E, nullptr);
#endif
        } break;
        case 1:
            for (;;) {
                const int it = next_item((unsigned*)(p.ws() + WS_CTR) + l, slot);
                if (it >= N_P2) break;
                if (it < N_ATT_P) { const int qi = 16 - it / 24, bh = it % 24;
#if PHMASK & 4
attn_prompt(p, l, bh / 6, bh % 6, qi, shm);
#endif
 }
                else if (it < N_ATT_P + N_ATT_S) { const int a = it - N_ATT_P;
#if PHMASK & 8
attn_sample(p, l, a / 6, a % 6, shm);
#endif
 }
                else if (it < N_ATT_P + N_ATT_S + N_SSD) { const int j = it - N_ATT_P - N_ATT_S; const int grp = j < NB * NCH ? 0 : 1; const int b = grp == 0 ? j / NCH : j - NB * NCH, c = grp == 0 ? j % NCH : 0;
#if PHMASK & 16
ssd_a(p, l, grp, b, c, shm);
#endif
 }
                else { const int j = it - N_ATT_P - N_ATT_S - N_SSD; const int grp = j < NB * NCH ? 0 : 1; const int b = grp == 0 ? j / NCH : j - NB * NCH, c = grp == 0 ? j % NCH : 0;
#if PHMASK & 32
pool_item(p, l, grp, b, c, shm);
#endif
 }
            }
            break;
        case 2:
#if PHMASK & 64
 ssd_scan(p, l);
#endif
 break;
        case 3:
            for (int j = blockIdx.x; j < N_SSD; j += gridDim.x) {
                const int grp = j < NB * NCH ? 0 : 1; const int b = grp == 0 ? j / NCH : j - NB * NCH, c = grp == 0 ? j % NCH : 0;
#if PHMASK & 128
                ssd_c(p, l, grp, b, c, shm); __syncthreads();
#endif
            }
            break;
        case 4: {
            pg8::Gemm g{(const bf16_t*)(p.ws() + WS_MIX), (const bf16_t*)(p.ws() + WS_WOUT + l * SZ_WOUT), MPAD, 1024, 1024};
            pg8::StaticOrder S; S.init(MPAD, 1024, (int)gridDim.x, (int)blockIdx.x);
            EpiF32 E{(float*)(p.ws() + WS_OUT), 1024};
#if PHMASK & 256
            pg8::gemm_phase<EpiF32, pg8::StaticOrder, false>(lds, g, S, E, nullptr);
#endif
        } break;
        case 5:
#if PHMASK & 512
 row_phase(p, 1, p.ln_post_mix() + (size_t)l * 1024, p.ln_pre_ffn() + (size_t)l * 1024, false);
#endif
 break;
        case 6: {
            pg8::Gemm g{(const bf16_t*)(p.ws() + WS_H), (const bf16_t*)(p.ws() + WS_WGU + l * SZ_WGU), MPAD, 2 * DFF, 1024};
            pg8::StaticOrder S; S.init(MPAD, 2 * DFF, (int)gridDim.x, (int)blockIdx.x);
            EpiGU E{(bf16_t*)(p.ws() + WS_HID)};
#if PHMASK & 1024
            pg8::gemm_phase<EpiGU, pg8::StaticOrder, false>(lds, g, S, E, nullptr);
#endif
        } break;
        case 7: {
            pg8::Gemm g{(const bf16_t*)(p.ws() + WS_HID), (const bf16_t*)(p.ws() + WS_WDN + l * SZ_WDN), MPAD, 1024, DFF};
            pg8::StaticOrder S; S.init(MPAD, 1024, (int)gridDim.x, (int)blockIdx.x);
            EpiF32 E{(float*)(p.ws() + WS_OUT), 1024};
#if PHMASK & 2048
            pg8::gemm_phase<EpiF32, pg8::StaticOrder, false>(lds, g, S, E, nullptr);
#endif
        } break;
        default:
#if PHMASK & 4096
 row_phase(p, 1, p.ln_post_ffn() + (size_t)l * 1024, p.ln_pre_mix() + (size_t)(l + 1 < DEPTH ? l + 1 : 0) * 1024, l + 1 == DEPTH);
#endif
 break;
        }
        if (ph + 1 < 1 + 9 * DEPTH) grid.sync();
    }
}

extern "C" void kernel_launch(void* const* d_in, const int* in_sizes, int n_in, void* d_out, int out_size, void* d_ws, size_t ws_size, hipStream_t stream) {
    static int grid_blocks = 0;
    if (!grid_blocks) {
        if (hipFuncSetAttribute((const void*)hymba_fwd, hipFuncAttributeMaxDynamicSharedMemorySize, (int)LDS_BYTES) != hipSuccess) { fprintf(stderr, "hipFuncSetAttribute failed\n"); return; }
        int dev = 0, cus = 0, per_cu = 0;
        hipGetDevice(&dev);
        hipDeviceGetAttribute(&cus, hipDeviceAttributeMultiprocessorCount, dev);
        if (hipOccupancyMaxActiveBlocksPerMultiprocessor(&per_cu, (const void*)hymba_fwd, 512, LDS_BYTES) != hipSuccess || per_cu < 1) { fprintf(stderr, "occupancy query failed\n"); return; }
        grid_blocks = cus * 1;
    }
    if (ws_size < WS_END) { fprintf(stderr, "workspace too small\n"); return; }
    Params p{};
    const float* const* in = (const float* const*)d_in;
    p.x_prompt = in[0]; p.x_sample = in[1]; p.cache_k = in[2]; p.cache_v = in[3]; p.cache_logf = in[4]; p.state_pool = in[5]; p.state_conv = in[6]; p.state_ssd = in[7];
    p.meta = in[8]; p.ln_pre_mix = in[9]; p.ln_post_mix = in[10]; p.ln_pre_ffn = in[11]; p.ln_post_ffn = in[12]; p.w_in = in[13]; p.fox_f_bias = in[14]; p.pool_w = in[15];
    p.pool_scale = in[16]; p.conv_w = in[17]; p.conv_b = in[18]; p.dt_bias = in[19]; p.a_log = in[20]; p.d_skip = in[21]; p.ssd_norm = in[22]; p.w_out = in[23];
    p.w_gate = in[24]; p.w_up = in[25]; p.w_down = in[26];
    p.out = (float*)d_out; p.ws = (unsigned char*)d_ws;
    hipMemsetAsync((unsigned char*)d_ws + WS_CTR, 0, 4096, stream);
    void* args[] = {&p};
    hipError_t e = hipLaunchCooperativeKernel((const void*)hymba_fwd, dim3(grid_blocks), dim3(512), args, LDS_BYTES, stream);
    if (e != hipSuccess) fprintf(stderr, "cooperative launch failed: %s (grid %d)\n", hipGetErrorString(e), grid_blocks);
}
```

```cpp
#include <hip/hip_runtime.h>
#include <hip/hip_cooperative_groups.h>
#include <cstdio>
#include <cstdint>
namespace pg8 {
#define PG8_LAS __attribute__((address_space(3)))
typedef unsigned short bf16_t;
typedef short bf16x8 __attribute__((ext_vector_type(8)));
typedef float f32x4 __attribute__((ext_vector_type(4)));
typedef unsigned u32x4 __attribute__((ext_vector_type(4)));
constexpr int BM = 256, BK = 64, HALF = 128, HTB = HALF * BK * 2  , STAGE_BYTES = 8 * HTB, NXCD = 8, WGM = 8;

__host__ __device__ __forceinline__ int lds_byte(int r, int c) { const int st = (r >> 4) * 2 + (c >> 5), rr = r & 15, cc = c & 31, ob = rr * 64 + cc * 2; return st * 1024 + (ob ^ (((ob >> 9) & 1) << 5)); }
__host__ __device__ __forceinline__ void stage_rc(int b, int& R, int& C) { const int st = b / 1024, sb = b % 1024, swz = sb ^ (((sb >> 9) & 1) << 5); R = (st >> 1) * 16 + swz / 64; C = (st & 1) * 32 + (swz % 64) / 2; }
__host__ __device__ __forceinline__ int perm32(int rho) { const int n = rho >> 4, i = rho & 15; return 8 * (i >> 2) + 4 * n + (i & 3); }

struct Unit { int pm, pn, nt, koff, slice; };
struct Gemm { const bf16_t* A; const bf16_t* Bt; int M, N, K; };

struct StaticOrder {
    int nM, nN, nwg, G, c, ntk;
    __host__ __device__ void init(int M, int N, int G_, int c_, int K_) { nM = M / BM; nN = N / BM; nwg = nM * nN; G = G_; c = c_; ntk = K_ / BK; }
    __host__ __device__ bool next(int i, Unit& u) const {
        const long L = (long)i * G + c; if (L >= nwg) return false;
        int wgid = (int)L; { const int q = nwg / NXCD, r = nwg % NXCD, xcd = wgid % NXCD, off = wgid / NXCD; wgid = (xcd < r ? xcd * (q + 1) : r * (q + 1) + (xcd - r) * q) + off; }
        const int nig = WGM * nN, gid = wgid / nig, fm = gid * WGM, gsz = (nM - fm) < WGM ? (nM - fm) : WGM;
        u.pm = fm + ((wgid % nig) % gsz); u.pn = (wgid % nig) / gsz; u.nt = ntk; u.koff = 0; u.slice = -1; return true;
    }
    __device__ __forceinline__ void a_ready(const Unit&) const {}
    __device__ __forceinline__ void done(const Unit&) const {}
};

template <class Epi, class Sched, bool STAMP = false>
__device__ __forceinline__ void gemm_phase(PG8_LAS unsigned char* lds, const Gemm g, const Sched& S, const Epi& E, unsigned long long* stamps) {
    int tid_ = threadIdx.x; asm volatile("" : "+v"(tid_));
    const int tid = tid_, wid = __builtin_amdgcn_readfirstlane(tid >> 6), lane = tid & 63, wr = wid >> 2, wc = wid & 3, fr = lane & 15, fq = lane >> 4;
    const int K = g.K;
    int ts_lo = 0, ts_hi = 0, nts = 0; const unsigned long long rt_entry = STAMP ? (unsigned long long)wall_clock64() : 0ull;
#define PG8_STAMP() do { if (STAMP && wid == 0 && nts < 64) { const unsigned long long _c = (unsigned long long)clock64(); \
        ts_lo = (lane == nts) ? (int)(unsigned)_c : ts_lo; ts_hi = (lane == nts) ? (int)(unsigned)(_c >> 32) : ts_hi; ++nts; } } while (0)
    PG8_STAMP();
    unsigned voffA[2], voffB[2];
#pragma unroll
    for (int i = 0; i < 2; ++i) { int R, C; stage_rc(tid * 16 + i * 8192, R, C); const int Rb = Epi::PERM ? ((R & ~31) + perm32(R & 31)) : R;
        voffA[i] = (unsigned)(R * K + C) * 2u; voffB[i] = (unsigned)(Rb * K + C) * 2u; }
    const size_t kstep = (size_t)(BK * 2);
    const size_t hstep = (size_t)HALF * K * 2;
    const size_t tstep = 2 * hstep;
    const unsigned ldsw = (unsigned)wid * 1024u;
    const int aoff = lds_byte(wr * 64 + fr, fq * 8), boff = lds_byte(wc * 32 + fr, fq * 8);
#define PG8_SA(b, h) (((b) * 2 + (h)) * HTB)
#define PG8_SB(b, h) ((4 + (b) * 2 + (h)) * HTB)
#define PG8_STAGE(bufoff, gbase, voff) do { _Pragma("unroll") for (int _i = 0; _i < 2; ++_i) \
        __builtin_amdgcn_global_load_lds((const unsigned*)((const char*)(gbase) + (voff)[_i]), (PG8_LAS unsigned*)(lds + (bufoff) + ldsw + _i * 8192), 16, 0, 0); } while (0)
#define PG8_LDA(dst, b, h) do { _Pragma("unroll") for (int m = 0; m < 4; ++m) _Pragma("unroll") for (int k = 0; k < 2; ++k) dst[m][k] = *(const PG8_LAS bf16x8*)(lds + PG8_SA(b, h) + aoff + m * 2048 + k * 1024); } while (0)
#define PG8_LDB(dst, b, h) do { _Pragma("unroll") for (int n = 0; n < 2; ++n) _Pragma("unroll") for (int k = 0; k < 2; ++k) dst[n][k] = *(const PG8_LAS bf16x8*)(lds + PG8_SB(b, h) + boff + n * 2048 + k * 1024); } while (0)
#define PG8_MMA(ai, bj, At, Bt) do { __builtin_amdgcn_s_setprio(1); _Pragma("unroll") for (int m = 0; m < 4; ++m) _Pragma("unroll") for (int n = 0; n < 2; ++n) _Pragma("unroll") for (int k = 0; k < 2; ++k) \
        acc[ai][bj][m][n] = __builtin_amdgcn_mfma_f32_16x16x32_bf16(Bt[n][k], At[m][k], acc[ai][bj][m][n], 0, 0, 0); __builtin_amdgcn_s_setprio(0); } while (0)
#define PG8_WAIT_V(n) asm volatile("s_waitcnt vmcnt(" #n ")" ::: "memory")
#define PG8_WAIT_L(n) asm volatile("s_waitcnt lgkmcnt(" #n ")" ::: "memory")
#define PG8_BAR __builtin_amdgcn_s_barrier()
#define PG8_SCHED __builtin_amdgcn_sched_barrier(0)
    Unit cur, nxt; int ui = 0;
    if (!S.next(0, cur)) return;
    f32x4 acc[2][2][4][2];
#pragma unroll
    for (int a = 0; a < 2; ++a)
#pragma unroll
        for (int b = 0; b < 2; ++b)
#pragma unroll
            for (int m = 0; m < 4; ++m)
#pragma unroll
                for (int n = 0; n < 2; ++n) acc[a][b][m][n] = (f32x4){0.f, 0.f, 0.f, 0.f};
    bf16x8 At[4][2], B0[2][2], B1[2][2];
    const char* cA = (const char*)g.A + (size_t)cur.pm * tstep + (size_t)cur.koff * 2; const char* cB = (const char*)g.Bt + (size_t)cur.pn * tstep + (size_t)cur.koff * 2;
    S.a_ready(cur);
    PG8_STAGE(PG8_SB(0, 0), cB, voffB); PG8_STAGE(PG8_SA(0, 0), cA, voffA); PG8_STAGE(PG8_SB(0, 1), cB + hstep, voffB); PG8_STAGE(PG8_SA(0, 1), cA + hstep, voffA);
    if (wr == 1) PG8_BAR;
    PG8_WAIT_V(4); PG8_BAR;
    PG8_STAGE(PG8_SB(1, 0), cB + kstep, voffB); PG8_STAGE(PG8_SA(1, 0), cA + kstep, voffA); PG8_STAGE(PG8_SB(1, 1), cB + hstep + kstep, voffB);
    PG8_WAIT_V(6); PG8_BAR;
    PG8_STAMP();
    for (;;) {
        const bool has_next = S.next(ui + 1, nxt);
        const char* nA = has_next ? (const char*)g.A + (size_t)nxt.pm * tstep + (size_t)nxt.koff * 2 : cA; const char* nB = has_next ? (const char*)g.Bt + (size_t)nxt.pn * tstep + (size_t)nxt.koff * 2 : cB;
        const int nt = cur.nt;
        for (int t = 0; t < nt; t += 2) {
            const bool last = (t == nt - 2);
            const char* a1 = cA + (size_t)(t + 1) * kstep;
            const char* a2 = last ? nA : cA + (size_t)(t + 2) * kstep; const char* b2 = last ? nB : cB + (size_t)(t + 2) * kstep;
            const char* a3 = a2 + kstep; const char* b3 = b2 + kstep;
            if (last && has_next) S.a_ready(nxt);
            PG8_LDB(B0, 0, 0); PG8_SCHED; PG8_LDA(At, 0, 0); PG8_STAGE(PG8_SA(1, 1), a1 + hstep, voffA);
            PG8_WAIT_L(8); PG8_BAR; PG8_WAIT_L(0); PG8_MMA(0, 0, At, B0); PG8_BAR; PG8_SCHED;
            PG8_LDB(B1, 0, 1); PG8_STAGE(PG8_SB(0, 0), b2, voffB);
            PG8_BAR; PG8_WAIT_L(0); PG8_MMA(0, 1, At, B1); PG8_BAR;
            PG8_LDA(At, 0, 1); PG8_STAGE(PG8_SA(0, 0), a2, voffA);
            PG8_BAR; PG8_WAIT_L(0); PG8_MMA(1, 0, At, B0); PG8_BAR; PG8_SCHED;
            PG8_STAGE(PG8_SB(0, 1), b2 + hstep, voffB);
            PG8_WAIT_V(6); PG8_BAR; PG8_MMA(1, 1, At, B1); PG8_BAR;
            PG8_LDB(B0, 1, 0); PG8_SCHED; PG8_LDA(At, 1, 0); PG8_STAGE(PG8_SA(0, 1), a2 + hstep, voffA);
            PG8_WAIT_L(8); PG8_BAR; PG8_WAIT_L(0); PG8_MMA(0, 0, At, B0); PG8_BAR; PG8_SCHED;
            PG8_LDB(B1, 1, 1); PG8_STAGE(PG8_SB(1, 0), b3, voffB);
            PG8_BAR; PG8_WAIT_L(0); PG8_MMA(0, 1, At, B1); PG8_BAR;
            PG8_LDA(At, 1, 1); PG8_STAGE(PG8_SA(1, 0), a3, voffA);
            PG8_BAR; PG8_WAIT_L(0); PG8_MMA(1, 0, At, B0); PG8_BAR; PG8_SCHED;
            PG8_STAGE(PG8_SB(1, 1), b3 + hstep, voffB);
            PG8_WAIT_V(6); PG8_BAR; PG8_MMA(1, 1, At, B1); PG8_BAR;
        }
        PG8_STAMP();
        if constexpr (!Epi::AFTER_DRAIN) {
            if (wr == 0) PG8_BAR;
            E(acc, cur, wr, wc, fr, fq); S.done(cur);
            if (wr == 1) PG8_BAR;
        }
        PG8_STAMP();
        if (!has_next) break;
#pragma unroll
        for (int a = 0; a < 2; ++a)
#pragma unroll
            for (int b = 0; b < 2; ++b)
#pragma unroll
                for (int m = 0; m < 4; ++m)
#pragma unroll
                    for (int n = 0; n < 2; ++n) acc[a][b][m][n] = (f32x4){0.f, 0.f, 0.f, 0.f};
        cur = nxt; cA = nA; cB = nB; ++ui;
    }
    PG8_WAIT_V(0);
    if (wr == 0) PG8_BAR;
    PG8_BAR;
    if constexpr (Epi::AFTER_DRAIN) { E.fused(acc, cur, wr, wc, fr, fq, lds, wid, lane); S.done(cur); }
    PG8_STAMP();
    if (STAMP && wid == 0) { stamps[lane] = lane < nts ? (((unsigned long long)(unsigned)ts_hi << 32) | (unsigned)ts_lo) : 0ull;
        if (lane == 62) stamps[62] = rt_entry; if (lane == 63) stamps[63] = (unsigned long long)wall_clock64(); }
#undef PG8_STAMP
#undef PG8_SA
#undef PG8_SB
#undef PG8_STAGE
#undef PG8_LDA
#undef PG8_LDB
#undef PG8_MMA
#undef PG8_WAIT_V
#undef PG8_WAIT_L
#undef PG8_BAR
#undef PG8_SCHED
}
}
#define XB_TMO      128
#define XB_XCNT(j)  (256  + 64 * (j))
#define XB_XSUB(j)  (1280 + 64 * (j))
#define XB_XGEN(j)  (2304 + 64 * (j))
#define XB_TOP      3328
#define XB_TOPGEN   3392
#define XCD_BAR_WORDS 3456
#define XB_SPIN_CAP (1u << 18)
#define LAS __attribute__((address_space(3)))

__device__ __forceinline__ unsigned xb_ld(unsigned* p)              { return __hip_atomic_load(p, __ATOMIC_RELAXED, __HIP_MEMORY_SCOPE_AGENT); }
__device__ __forceinline__ unsigned xb_add(unsigned* p, unsigned v) { return __hip_atomic_fetch_add(p, v, __ATOMIC_RELAXED, __HIP_MEMORY_SCOPE_AGENT); }
__device__ __forceinline__ unsigned xb_xcc_id() { return (unsigned)__builtin_amdgcn_s_getreg((3 << 11) | 20) & 0xFu; }
#define XB_SPIN(cond, bar) do { unsigned _sp = 0; while (cond) { __builtin_amdgcn_s_sleep(1); \
    if ((++_sp & 255u) == 0u) { if (xb_ld(&(bar)[XB_TMO])) break; if (_sp > XB_SPIN_CAP) { atomicAdd(&(bar)[XB_TMO], 1u); break; } } } } while (0)

struct XcdBarrier {
    unsigned* bar; unsigned x;
    volatile LAS unsigned* st;
};

__device__ __forceinline__ XcdBarrier xcd_barrier_post(unsigned* bar, volatile LAS unsigned* st) {
    XcdBarrier b; b.bar = bar; b.x = xb_xcc_id(); b.st = st;
    if (threadIdx.x == 0) (void)xb_add(&bar[XB_XCNT(b.x)], 1u);
    return b;
}
__device__ __forceinline__ void xcd_barrier_complete(unsigned* bar, unsigned x, unsigned& nloc, unsigned& nx) {
    const unsigned G = gridDim.x * gridDim.y * gridDim.z;
    unsigned sum, cnt, mine, sp = 0u;
    for (;;) {
        sum = 0u; cnt = 0u; mine = 0u;
#pragma unroll
        for (unsigned j = 0; j < 16; ++j) { const unsigned c = xb_ld(&bar[XB_XCNT(j)]); sum += c; cnt += (c > 0u) ? 1u : 0u; mine = (j == x) ? c : mine; }
        if (sum == G) break;
        __builtin_amdgcn_s_sleep(1);
        if ((++sp & 255u) == 0u) { if (xb_ld(&bar[XB_TMO])) break; if (sp > XB_SPIN_CAP) { atomicAdd(&bar[XB_TMO], 1u); break; } }
    }
    nloc = mine > 0u ? mine : 1u; nx = cnt > 0u ? cnt : 1u;
}

__device__ __forceinline__ void xcd_barrier(const XcdBarrier& b) {
    asm volatile("s_waitcnt vmcnt(0)" ::: "memory");
    __syncthreads();
    if (threadIdx.x == 0) {
        unsigned* bar = b.bar;
        __builtin_amdgcn_s_waitcnt(0);
        unsigned nloc = b.st[0], nx = b.st[1];
        if (nloc == 0u) { xcd_barrier_complete(bar, b.x, nloc, nx); b.st[0] = nloc; b.st[1] = nx; }
        const unsigned old = xb_add(&bar[XB_XSUB(b.x)], 1u);
        const unsigned gen = old / nloc;
        if (old + 1u == (gen + 1u) * nloc) {
            __builtin_amdgcn_fence(__ATOMIC_RELEASE, "agent");
            asm volatile("s_waitcnt vmcnt(0)" ::: "memory");
            const unsigned og = xb_add(&bar[XB_TOP], 1u);
            const unsigned tg = og / nx;
            if (og + 1u == (tg + 1u) * nx) xb_add(&bar[XB_TOPGEN], 1u);
            else XB_SPIN(xb_ld(&bar[XB_TOPGEN]) == tg, bar);
            __builtin_amdgcn_fence(__ATOMIC_ACQUIRE, "agent");
            xb_add(&bar[XB_XGEN(b.x)], 1u);
            asm volatile("s_waitcnt vmcnt(0)" ::: "memory");
        } else {
            XB_SPIN(xb_ld(&bar[XB_XGEN(b.x)]) == gen, bar);
            __builtin_amdgcn_fence(__ATOMIC_ACQUIRE, "agent");
            asm volatile("s_waitcnt vmcnt(0)" ::: "memory");
        }
    }
    __syncthreads();
}

namespace cg = cooperative_groups;
using pg8::bf16_t; using pg8::bf16x8; using pg8::f32x4; using pg8::u32x4;
typedef float f32x16 __attribute__((ext_vector_type(16)));
typedef unsigned u32x2 __attribute__((ext_vector_type(2)));
#define MFMA32(a, b, c) __builtin_amdgcn_mfma_f32_32x32x16_bf16((a), (b), (c), 0, 0, 0)
#define DI __device__ __forceinline__

constexpr int DMODEL = 1024, NB = 4, SEQ = 4096, NMETA = 16, TP = SEQ + NMETA, DEPTH = 4, DB = 32, DS = 32, PAST = 1024;
constexpr int MP = NB * TP, MS = DB * DS, MTOT = MP + MS, MPAD = 17664;
constexpr int NPROJ = 2560, DFF = 2816, NCH = 65, MMAIN = 16384, MTAILP = 1280;
constexpr int CK_ = 384, CV_ = 768, CU_ = 1152, CZ_ = 1408, CX_ = 1792, CF_ = 2432, CDT_ = 2440;
constexpr float EPS = 1e-6f, LOG2E = 1.4426950408889634f, QSCALE = 0.125f * 1.4426950408889634f;
constexpr size_t OFF_Y = 0, OFF_YS = OFF_Y + (size_t)NB * SEQ * 1024, OFF_KP = OFF_YS + (size_t)DB * DS * 1024,
                 OFF_VP = OFF_KP + (size_t)DEPTH * MP * 384, OFF_LP = OFF_VP + (size_t)DEPTH * MP * 384, OFF_PP = OFF_LP + (size_t)DEPTH * MP * 6,
                 OFF_CP = OFF_PP + (size_t)DEPTH * NB * 15 * 256, OFF_SP = OFF_CP + (size_t)DEPTH * NB * 3 * 640, OFF_KS = OFF_SP + (size_t)DEPTH * NB * 6 * 4096,
                 OFF_VS = OFF_KS + (size_t)DEPTH * MS * 384, OFF_LS = OFF_VS + (size_t)DEPTH * MS * 384, OFF_PS = OFF_LS + (size_t)DEPTH * MS * 6,
                 OFF_CS = OFF_PS + (size_t)DEPTH * DB * 15 * 256, OFF_SS = OFF_CS + (size_t)DEPTH * DB * 3 * 640;
constexpr size_t al256(size_t x) { return (x + 255) & ~(size_t)255; }
constexpr size_t WS_CTR = 0, WS_BAR = 4096, WS_WIN = 4096 + 16384, SZ_WIN = (size_t)NPROJ * 1024 * 2, WS_WOUT = WS_WIN + DEPTH * SZ_WIN, SZ_WOUT = (size_t)1024 * 1024 * 2,
                 WS_WGU = WS_WOUT + DEPTH * SZ_WOUT, SZ_WGU = (size_t)2 * DFF * 1024 * 2, WS_WDN = WS_WGU + DEPTH * SZ_WGU, SZ_WDN = (size_t)1024 * DFF * 2,
                 WS_PWT = WS_WDN + DEPTH * SZ_WDN, WS_X = WS_PWT + (size_t)DEPTH * 4 * 4096 * 2, WS_H = WS_X + (size_t)MPAD * 1024 * 4,
                 WS_PROJ = WS_H + (size_t)MPAD * 1024 * 2, WS_VT = WS_PROJ + (size_t)MPAD * NPROJ * 2, WS_DT = WS_VT + al256((size_t)NB * 6 * 64 * 4160 * 2),
                 WS_MIX = WS_DT + (size_t)MPAD * 8 * 4, WS_OUT = WS_MIX + (size_t)MPAD * 1024 * 2, WS_HID = WS_OUT + (size_t)MPAD * 1024 * 4,
                 WS_Y32 = WS_HID + (size_t)MPAD * DFF * 2, WS_CC = WS_Y32 + (size_t)MPAD * 384 * 4, WS_ACS = WS_CC + (size_t)MPAD * 128 * 2,
                 WS_ST = WS_ACS + (size_t)MPAD * 8 * 4, WS_PART = WS_ST + (size_t)NB * NCH * 6 * 4096 * 4, WS_RSTD = WS_PART + (size_t)11 * 1280 * 1024 * 4, WS_END = WS_RSTD + (size_t)MPAD * 4;

struct Params {
    const float *x_prompt, *x_sample, *cache_k, *cache_v, *cache_logf, *state_pool, *state_conv, *state_ssd, *meta, *ln_pre_mix, *ln_post_mix, *ln_pre_ffn, *ln_post_ffn,
        *w_in, *fox_f_bias, *pool_w, *pool_scale, *conv_w, *conv_b, *dt_bias, *a_log, *d_skip, *ssd_norm, *w_out, *w_gate, *w_up, *w_down;
    float* out; unsigned char* ws;
};

typedef __attribute__((address_space(4))) const volatile unsigned long long kav_t;
__device__ __forceinline__ unsigned long long karg_raw(int idx) { kav_t* ka = (kav_t*)__builtin_amdgcn_kernarg_segment_ptr(); return ka[idx]; }
struct PV {
    __device__ __forceinline__ const float* x_prompt() const { return (const float*)(__attribute__((address_space(1))) const float*)karg_raw(0); }
    __device__ __forceinline__ const float* x_sample() const { return (const float*)(__attribute__((address_space(1))) const float*)karg_raw(1); }
    __device__ __forceinline__ const float* cache_k() const { return (const float*)(__attribute__((address_space(1))) const float*)karg_raw(2); }
    __device__ __forceinline__ const float* cache_v() const { return (const float*)(__attribute__((address_space(1))) const float*)karg_raw(3); }
    __device__ __forceinline__ const float* cache_logf() const { return (const float*)(__attribute__((address_space(1))) const float*)karg_raw(4); }
    __device__ __forceinline__ const float* state_pool() const { return (const float*)(__attribute__((address_space(1))) const float*)karg_raw(5); }
    __device__ __forceinline__ const float* state_conv() const { return (const float*)(__attribute__((address_space(1))) const float*)karg_raw(6); }
    __device__ __forceinline__ const float* state_ssd() const { return (const float*)(__attribute__((address_space(1))) const float*)karg_raw(7); }
    __device__ __forceinline__ const float* meta() const { return (const float*)(__attribute__((address_space(1))) const float*)karg_raw(8); }
    __device__ __forceinline__ const float* ln_pre_mix() const { return (const float*)(__attribute__((address_space(1))) const float*)karg_raw(9); }
    __device__ __forceinline__ const float* ln_post_mix() const { return (const float*)(__attribute__((address_space(1))) const float*)karg_raw(10); }
    __device__ __forceinline__ const float* ln_pre_ffn() const { return (const float*)(__attribute__((address_space(1))) const float*)karg_raw(11); }
    __device__ __forceinline__ const float* ln_post_ffn() const { return (const float*)(__attribute__((address_space(1))) const float*)karg_raw(12); }
    __device__ __forceinline__ const float* w_in() const { return (const float*)(__attribute__((address_space(1))) const float*)karg_raw(13); }
    __device__ __forceinline__ const float* fox_f_bias() const { return (const float*)(__attribute__((address_space(1))) const float*)karg_raw(14); }
    __device__ __forceinline__ const float* pool_w() const { return (const float*)(__attribute__((address_space(1))) const float*)karg_raw(15); }
    __device__ __forceinline__ const float* pool_scale() const { return (const float*)(__attribute__((address_space(1))) const float*)karg_raw(16); }
    __device__ __forceinline__ const float* conv_w() const { return (const float*)(__attribute__((address_space(1))) const float*)karg_raw(17); }
    __device__ __forceinline__ const float* conv_b() const { return (const float*)(__attribute__((address_space(1))) const float*)karg_raw(18); }
    __device__ __forceinline__ const float* dt_bias() const { return (const float*)(__attribute__((address_space(1))) const float*)karg_raw(19); }
    __device__ __forceinline__ const float* a_log() const { return (const float*)(__attribute__((address_space(1))) const float*)karg_raw(20); }
    __device__ __forceinline__ const float* d_skip() const { return (const float*)(__attribute__((address_space(1))) const float*)karg_raw(21); }
    __device__ __forceinline__ const float* ssd_norm() const { return (const float*)(__attribute__((address_space(1))) const float*)karg_raw(22); }
    __device__ __forceinline__ const float* w_out() const { return (const float*)(__attribute__((address_space(1))) const float*)karg_raw(23); }
    __device__ __forceinline__ const float* w_gate() const { return (const float*)(__attribute__((address_space(1))) const float*)karg_raw(24); }
    __device__ __forceinline__ const float* w_up() const { return (const float*)(__attribute__((address_space(1))) const float*)karg_raw(25); }
    __device__ __forceinline__ const float* w_down() const { return (const float*)(__attribute__((address_space(1))) const float*)karg_raw(26); }
    __device__ __forceinline__ float* out() const { return (float*)(__attribute__((address_space(1))) float*)karg_raw(27); }
    __device__ __forceinline__ unsigned char* ws() const { return (unsigned char*)(__attribute__((address_space(1))) unsigned char*)karg_raw(28); }
};

#define AS_G(ptr) ((float*)(__attribute__((address_space(1))) float*)(ptr))
DI unsigned pack2(float lo, float hi) {
    typedef __bf16 bf2_t __attribute__((ext_vector_type(2))); typedef float fl2_t __attribute__((ext_vector_type(2)));
    fl2_t f = {lo, hi}; bf2_t b = __builtin_convertvector(f, bf2_t); return __builtin_bit_cast(unsigned, b);
}
DI float bf_lo(unsigned u) { return __uint_as_float(u << 16); }
DI float bf_hi(unsigned u) { return __uint_as_float(u & 0xffff0000u); }
DI bf16_t f2bf(float f) { return (bf16_t)(pack2(f, 0.f) & 0xffffu); }
DI float bf2f(bf16_t b) { return __uint_as_float(((unsigned)b) << 16); }
DI bf16x8 pack8(float a0, float a1, float a2, float a3, float a4, float a5, float a6, float a7) {
    u32x4 w = {pack2(a0, a1), pack2(a2, a3), pack2(a4, a5), pack2(a6, a7)}; return __builtin_bit_cast(bf16x8, w);
}
DI bf16x8 cat8(u32x2 lo, u32x2 hi) { u32x4 w = {lo.x, lo.y, hi.x, hi.y}; return __builtin_bit_cast(bf16x8, w); }
DI int crow(int i, int hi) { return (i & 3) + 8 * (i >> 2) + 4 * hi; }
DI float dpp_f(float src, int ctrl_unused) { return src; }
#define DPP_F(SRC, CTRL, RM, BC) __int_as_float(__builtin_amdgcn_update_dpp(0, __float_as_int(SRC), (CTRL), (RM), 0xf, (BC)))
DI float wave_scan_incl(float v, int lane) {
    (void)lane;
    v += DPP_F(v, 0x111, 0xf, true);
    v += DPP_F(v, 0x112, 0xf, true);
    v += DPP_F(v, 0x114, 0xf, true);
    v += DPP_F(v, 0x118, 0xf, true);
    v += DPP_F(v, 0x142, 0xa, false);
    v += DPP_F(v, 0x143, 0xc, false);
    return v;
}
DI float wave_sum(float v) { return __int_as_float(__builtin_amdgcn_readlane(__float_as_int(wave_scan_incl(v, 0)), 63)); }
DI float siluf(float x) { return x * __builtin_amdgcn_rcpf(1.f + __expf(-x)); }
DI float ex2(float x) { return __builtin_amdgcn_exp2f(x); }

DI int map_in_col(int n) {
    if (n < 1152) return n;
    if (n < 1408) return 1158 + (n - 1152);
    if (n < 1792) return 1414 + (n - 1408);
    if (n < 2432) return 1798 + (n - 1792);
    if (n < 2438) return 1152 + (n - 2432);
    if (n >= 2440 && n < 2446) return 2438 + (n - 2440);
    return -1;
}
template <int KT> DI void conv_tile(const float* W, int N, int K, int k0, int n0, int srcbase, bf16_t* out, float* tile, const float* gain = nullptr) {
    int tid_ = threadIdx.x; asm volatile("" : "+v"(tid_)); const int tid = tid_;
    const int nn = tid & 63, kb = tid >> 6; const int src = srcbase >= 0 ? srcbase + nn : map_in_col(n0 + nn);
    const float* wp = W + (size_t)(k0 + kb) * N + (src >= 0 ? src : 0);
#pragma unroll
    for (int i = 0; i < KT / 8; ++i) { float v = src >= 0 ? wp[(size_t)i * 8 * N] : 0.f; if (gain) v *= gain[k0 + kb + 8 * i]; tile[nn * (KT + 1) + kb + 8 * i] = v; }
    __syncthreads();
    { const int rn = tid >> 3, kq = tid & 7;
#pragma unroll
      for (int kc = 0; kc < KT / 64; ++kc) { const float* t = tile + rn * (KT + 1) + kc * 64 + kq * 8;
          u32x4 w = {pack2(t[0], t[1]), pack2(t[2], t[3]), pack2(t[4], t[5]), pack2(t[6], t[7])};
          *(u32x4*)(out + (size_t)(n0 + rn) * K + k0 + kc * 64 + kq * 8) = w; } }
    __syncthreads();
}
DI void phase0_weights(const PV& p, unsigned char* shm) {
    float* tile = (float*)shm;
    constexpr int PER = 160 + 64 + 352 + 176 + 4;
    for (int it = blockIdx.x; it < DEPTH * PER; it += gridDim.x) {
        const int l = it / PER; int j = it - l * PER;
        if (j < 160) { conv_tile<256>(p.w_in() + (size_t)l * 1024 * 2444, 2444, 1024, (j & 3) * 256, (j >> 2) * 64, -1, (bf16_t*)(p.ws() + WS_WIN + l * SZ_WIN), tile, p.ln_pre_mix() + (size_t)l * 1024); continue; }
        j -= 160;
        if (j < 64) { conv_tile<256>(p.w_out() + (size_t)l * 1024 * 1024, 1024, 1024, (j & 3) * 256, (j >> 2) * 64, (j >> 2) * 64, (bf16_t*)(p.ws() + WS_WOUT + l * SZ_WOUT), tile); continue; }
        j -= 64;
        if (j < 352) { const int n0 = (j >> 2) * 64, t256 = n0 >> 8, within = n0 & 255;
            const float* src = (within < 128 ? p.w_gate() : p.w_up()) + (size_t)l * 1024 * DFF;
            conv_tile<256>(src, DFF, 1024, (j & 3) * 256, n0, 128 * t256 + (within & 127), (bf16_t*)(p.ws() + WS_WGU + l * SZ_WGU), tile, p.ln_pre_ffn() + (size_t)l * 1024); continue; }
        j -= 352;
        if (j < 176) { const int nt = j / 11, kt = j - nt * 11; conv_tile<256>(p.w_down() + (size_t)l * DFF * 1024, 1024, DFF, kt * 256, nt * 64, nt * 64, (bf16_t*)(p.ws() + WS_WDN + l * SZ_WDN), tile); continue; }
        j -= 176;
        conv_tile<64>(p.pool_w() + (size_t)(l * 4 + j) * 4096, 64, 64, 0, 0, 0, (bf16_t*)(p.ws() + WS_PWT) + (size_t)(l * 4 + j) * 4096, tile);
    }
}

DI const float* row_src(const PV& p, int r) {
    if (r < MP) { const int b = r / TP, t = r - b * TP; return t < NMETA ? p.meta() + (size_t)t * 1024 : p.x_prompt() + ((size_t)b * SEQ + (t - NMETA)) * 1024; }
    return p.x_sample() + (size_t)(r - MP) * 1024;
}
DI f32x4 bf4(u32x2 w) { return (f32x4){bf_lo(w.x), bf_hi(w.x), bf_lo(w.y), bf_hi(w.y)}; }
DI void row_finish(const PV& p, int r, int lane, int mode, bool final, const f32x4 (&xo)[4], const f32x4 (&o)[4], const f32x4 (&gp)[4], bf16_t* XB, float* RSTD) {
    f32x4 x[4];
    if (mode) {
        float ss = 0.f;
#pragma unroll
        for (int j = 0; j < 4; ++j) ss += o[j][0] * o[j][0] + o[j][1] * o[j][1] + o[j][2] * o[j][2] + o[j][3] * o[j][3];
        ss = wave_sum(ss); const float rs = rsqrtf(ss * (1.f / 1024.f) + EPS);
#pragma unroll
        for (int j = 0; j < 4; ++j) x[j] = xo[j] + o[j] * rs * gp[j];
    } else {
#pragma unroll
        for (int j = 0; j < 4; ++j) x[j] = xo[j];
    }
    if (final) {
        float* dst = nullptr;
        if (r < MP) { const int b = r / TP, t = r - b * TP; if (t >= NMETA) dst = p.out() + OFF_Y + ((size_t)b * SEQ + (t - NMETA)) * 1024; }
        else dst = p.out() + OFF_YS + (size_t)(r - MP) * 1024;
        if (dst) {
#pragma unroll
            for (int j = 0; j < 4; ++j) *(f32x4*)(dst + 4 * (lane + 64 * j)) = x[j];
        }
    } else {
        float ss = 0.f;
#pragma unroll
        for (int j = 0; j < 4; ++j) ss += x[j][0] * x[j][0] + x[j][1] * x[j][1] + x[j][2] * x[j][2] + x[j][3] * x[j][3];
        ss = wave_sum(ss);
        if (lane == 0) RSTD[r] = rsqrtf(ss * (1.f / 1024.f) + EPS);
#pragma unroll
        for (int j = 0; j < 4; ++j) { u32x2 w = {pack2(x[j][0], x[j][1]), pack2(x[j][2], x[j][3])}; *(u32x2*)(XB + (size_t)r * 1024 + 4 * (lane + 64 * j)) = w; }
    }
}
DI void row_phase(const PV& p, int mode, const float* gpost, bool final, int nsplit, bool dry = false) {
    int tid_ = threadIdx.x; asm volatile("" : "+v"(tid_));
    const int lane = tid_ & 63, gw = blockIdx.x * 8 + (tid_ >> 6), nw = gridDim.x * 8;
    bf16_t* XB = (bf16_t*)(p.ws() + WS_H); const bf16_t* OUTB = (const bf16_t*)(p.ws() + WS_OUT); const float* PART = (const float*)(p.ws() + WS_PART); float* RSTD = (float*)(p.ws() + WS_RSTD);
    bf16_t* XW = dry ? (bf16_t*)(p.ws() + WS_X) : XB; float* RW = dry ? (float*)(p.ws() + WS_X + (size_t)MPAD * 2048) : RSTD;
    f32x4 gp[4];
#pragma unroll
    for (int j = 0; j < 4; ++j) gp[j] = mode ? *(const f32x4*)(gpost + 4 * (lane + 64 * j)) : (f32x4){0.f, 0.f, 0.f, 0.f};
    for (int r0 = gw; r0 < MMAIN; r0 += 4 * nw) {
        if (mode) {
            u32x2 xr[4][4], orr[4][4];
#pragma unroll
            for (int k = 0; k < 4; ++k) { const int r = r0 + k * nw < MMAIN ? r0 + k * nw : r0;
#pragma unroll
                for (int j = 0; j < 4; ++j) { xr[k][j] = *(const u32x2*)(XB + (size_t)r * 1024 + 4 * (lane + 64 * j)); orr[k][j] = *(const u32x2*)(OUTB + (size_t)r * 1024 + 4 * (lane + 64 * j)); } }
#pragma unroll
            for (int k = 0; k < 4; ++k) { const int r = r0 + k * nw;
                if (r < MMAIN) { f32x4 xo[4], o[4];
#pragma unroll
                    for (int j = 0; j < 4; ++j) { xo[j] = bf4(xr[k][j]); o[j] = bf4(orr[k][j]); }
                    row_finish(p, r, lane, 1, final, xo, o, gp, XW, RW); } }
        } else {
            f32x4 xf[4][4];
#pragma unroll
            for (int k = 0; k < 4; ++k) { const int r = r0 + k * nw < MMAIN ? r0 + k * nw : r0; const float* src = row_src(p, r);
#pragma unroll
                for (int j = 0; j < 4; ++j) xf[k][j] = *(const f32x4*)(src + 4 * (lane + 64 * j)); }
#pragma unroll
            for (int k = 0; k < 4; ++k) { const int r = r0 + k * nw; if (r < MMAIN) row_finish(p, r, lane, 0, false, xf[k], gp, gp, XW, RW); }
        }
    }
    for (int r = MMAIN + gw; r < MTOT; r += nw) {
        f32x4 xo[4], o[4];
        if (mode) {
            const float* pp = PART + (size_t)(r - MMAIN) * 1024 + 4 * lane;
#pragma unroll
            for (int j = 0; j < 4; ++j) { xo[j] = bf4(*(const u32x2*)(XB + (size_t)r * 1024 + 4 * (lane + 64 * j))); o[j] = (f32x4){0.f, 0.f, 0.f, 0.f}; }
#pragma unroll 1
            for (int s0 = 0; s0 < nsplit; s0 += 4) {
                f32x4 t[4][4];
#pragma unroll
                for (int s = 0; s < 4; ++s) { const int ss = s0 + s < nsplit ? s0 + s : nsplit - 1;
#pragma unroll
                    for (int j = 0; j < 4; ++j) t[s][j] = *(const f32x4*)(pp + (size_t)ss * MTAILP * 1024 + 256 * j); }
#pragma unroll
                for (int s = 0; s < 4; ++s) { const float wgt = s0 + s < nsplit ? 1.f : 0.f;
#pragma unroll
                    for (int j = 0; j < 4; ++j) o[j] += t[s][j] * wgt; }
            }
        } else {
            const float* src = row_src(p, r);
#pragma unroll
            for (int j = 0; j < 4; ++j) { xo[j] = *(const f32x4*)(src + 4 * (lane + 64 * j)); o[j] = (f32x4){0.f, 0.f, 0.f, 0.f}; }
        }
        row_finish(p, r, lane, mode, final, xo, o, gp, XW, RW);
    }
}

struct EpiOutB {
    static constexpr bool PERM = true, AFTER_DRAIN = false;
    bf16_t* C; float* part;
    DI void operator()(const f32x4 (&acc)[2][2][4][2], const pg8::Unit& u, int wr, int wc, int fr, int fq) const {
        const int row0 = u.pm * 256 + wr * 64 + fr, col0 = u.pn * 256 + wc * 32 + 8 * fq;
        if (u.slice < 0) {
#pragma unroll
            for (int ai = 0; ai < 2; ++ai)
#pragma unroll
                for (int m = 0; m < 4; ++m)
#pragma unroll
                    for (int bj = 0; bj < 2; ++bj) { const f32x4 v0 = acc[ai][bj][m][0], v1 = acc[ai][bj][m][1];
                        u32x4 w = {pack2(v0[0], v0[1]), pack2(v0[2], v0[3]), pack2(v1[0], v1[1]), pack2(v1[2], v1[3])};
                        *(u32x4*)(C + (size_t)(row0 + ai * 128 + m * 16) * 1024 + col0 + bj * 128) = w; }
        } else {
            float* base = part + ((size_t)u.slice * MTAILP + (row0 - MMAIN)) * 1024 + col0;
#pragma unroll
            for (int ai = 0; ai < 2; ++ai)
#pragma unroll
                for (int m = 0; m < 4; ++m)
#pragma unroll
                    for (int bj = 0; bj < 2; ++bj) { float* d = base + (size_t)(ai * 128 + m * 16) * 1024 + bj * 128; *(f32x4*)d = acc[ai][bj][m][0]; *(f32x4*)(d + 4) = acc[ai][bj][m][1]; }
        }
    }
};
struct SplitOrder {
    int S, ntMain, G, c;
    DI bool next(int i, pg8::Unit& u) const {
        long L = (long)i * G + c;
        if (L < 256) { int l = (int)L; if (G == 256) { const int x = l & 7, j = l >> 3; u.pm = 8 * x + (j >> 2); u.pn = j & 3; } else { u.pm = l >> 2; u.pn = l & 3; }
            u.nt = ntMain; u.koff = 0; u.slice = -1; return true; }
        L -= 256; if (L >= 20 * S) return false;
        const int l = (int)L, s = l % S, tt = l / S; u.pm = 64 + (tt >> 2); u.pn = tt & 3; u.nt = 4; u.koff = s * 256; u.slice = s; return true;
    }
    DI void a_ready(const pg8::Unit&) const {}
    DI void done(const pg8::Unit&) const {}
};
struct EpiGU {
    static constexpr bool PERM = true, AFTER_DRAIN = false;
    bf16_t* O; const float* rstd;
    DI void operator()(const f32x4 (&acc)[2][2][4][2], const pg8::Unit& u, int wr, int wc, int fr, int fq) const {
        const int row0 = u.pm * 256 + wr * 64 + fr, col0 = u.pn * 128 + wc * 32 + 8 * fq;
#pragma unroll
        for (int ai = 0; ai < 2; ++ai)
#pragma unroll
            for (int m = 0; m < 4; ++m) {
                const float rs = rstd[row0 + ai * 128 + m * 16];
                const f32x4 g0 = acc[ai][0][m][0] * rs, g1 = acc[ai][0][m][1] * rs, u0 = acc[ai][1][m][0] * rs, u1 = acc[ai][1][m][1] * rs;
                u32x4 w = {pack2(siluf(g0[0]) * u0[0], siluf(g0[1]) * u0[1]), pack2(siluf(g0[2]) * u0[2], siluf(g0[3]) * u0[3]),
                           pack2(siluf(g1[0]) * u1[0], siluf(g1[1]) * u1[1]), pack2(siluf(g1[2]) * u1[2], siluf(g1[3]) * u1[3])};
                *(u32x4*)(O + (size_t)(row0 + ai * 128 + m * 16) * DFF + col0) = w;
            }
    }
};
DI float log_sigmoid(float x) { return fminf(x, 0.f) - log1pf(expf(-fabsf(x))); }
DI float softplusf(float x) { return fmaxf(x, 0.f) + log1pf(expf(-fabsf(x))); }
struct EpiIn {
    static constexpr bool PERM = true, AFTER_DRAIN = false;
    bf16_t* proj; bf16_t* vt; float* dtb; const float* fbias; const float* dtbias; const float* rstd;
    float *kp_, *ks_, *vp_, *vs_, *lp_, *ls_, *pp_, *ps_, *cp_, *cs_;
    DI void operator()(const f32x4 (&acc)[2][2][4][2], const pg8::Unit& u, int wr, int wc, int fr, int fq) const {
        unsigned long long a0 = (unsigned long long)kp_, a1 = (unsigned long long)ks_, a2 = (unsigned long long)vp_, a3 = (unsigned long long)vs_, a4 = (unsigned long long)lp_,
                           a5 = (unsigned long long)ls_, a6 = (unsigned long long)pp_, a7 = (unsigned long long)ps_, a8 = (unsigned long long)cp_, a9 = (unsigned long long)cs_;
        asm volatile("" : "+s"(a0), "+s"(a1), "+s"(a2), "+s"(a3), "+s"(a4)); asm volatile("" : "+s"(a5), "+s"(a6), "+s"(a7), "+s"(a8), "+s"(a9));
        float *kp = AS_G(a0), *ks = AS_G(a1), *vp = AS_G(a2), *vs = AS_G(a3), *lp = AS_G(a4), *ls = AS_G(a5), *pp = AS_G(a6), *ps = AS_G(a7), *cp = AS_G(a8), *cs = AS_G(a9);
#pragma unroll
        for (int ai = 0; ai < 2; ++ai)
#pragma unroll
            for (int m = 0; m < 4; ++m) {
                const int r = u.pm * 256 + ai * 128 + wr * 64 + m * 16 + fr;
                const bool valid = r < MTOT, isP = r < MP;
                int b, t; if (isP) { b = r / TP; t = r - b * TP; } else { const int rs = r - MP; b = rs >> 5; t = rs & 31; }
                const int rr = isP ? r : r - MP; const float rsr = rstd[r];
#pragma unroll
                for (int bj = 0; bj < 2; ++bj) {
                    const int cb = u.pn * 256 + bj * 128, c0 = cb + wc * 32 + fq * 8;
                    const f32x4 v0 = acc[ai][bj][m][0] * rsr, v1 = acc[ai][bj][m][1] * rsr;
                    if (cb < CF_) {
                        const float sc = cb < CK_ ? QSCALE : 1.f;
                        u32x4 w = {pack2(v0[0] * sc, v0[1] * sc), pack2(v0[2] * sc, v0[3] * sc), pack2(v1[0] * sc, v1[1] * sc), pack2(v1[2] * sc, v1[3] * sc)};
                        *(u32x4*)(proj + (size_t)r * NPROJ + c0) = w;
                        if (valid) {
                            if (cb >= CK_ && cb < CV_) {
                            } else if (cb >= CV_ && cb < CU_) {
                            } else if (cb >= CU_ && cb < CZ_) {
                                const int tt = isP ? t - (TP - 15) : t - (DS - 15);
                                if (tt >= 0) { float* d = (isP ? pp : ps) + (size_t)(b * 15 + tt) * 256 + (c0 - CU_); *(f32x4*)d = v0; *(f32x4*)(d + 4) = v1; }
                            } else if (cb >= CX_) {
                                const int tt = isP ? t - (TP - 3) : t - (DS - 3);
                                if (tt >= 0) { float* d = (isP ? cp : cs) + (size_t)(b * 3 + tt) * 640 + (c0 - CX_); *(f32x4*)d = v0; *(f32x4*)(d + 4) = v1; }
                            }
                        }
                    } else if (cb == CF_) {
                        if (valid && c0 == CF_) {
                            float* d = (isP ? lp : ls) + (size_t)rr * 6;
                            d[0] = log_sigmoid(v0[0] + fbias[0]); d[1] = log_sigmoid(v0[1] + fbias[1]); d[2] = log_sigmoid(v0[2] + fbias[2]); d[3] = log_sigmoid(v0[3] + fbias[3]);
                            d[4] = log_sigmoid(v1[0] + fbias[4]); d[5] = log_sigmoid(v1[1] + fbias[5]);
                        }
                        if (c0 == CDT_) {
                            float* d = dtb + (size_t)r * 8;
                            d[0] = softplusf(v0[0] + dtbias[0]); d[1] = softplusf(v0[1] + dtbias[1]); d[2] = softplusf(v0[2] + dtbias[2]); d[3] = softplusf(v0[3] + dtbias[3]);
                            d[4] = softplusf(v1[0] + dtbias[4]); d[5] = softplusf(v1[1] + dtbias[5]);
                        }
                    }
                }
                __builtin_amdgcn_sched_barrier(0);
            }
    }
};
constexpr int ABUF = 18688;
DI void attn_prompt(const PV& p, int l, int b, int h, int qi, unsigned char* shm) {
    int tid_ = threadIdx.x; asm volatile("" : "+v"(tid_)); const int tid = tid_, wid = tid >> 6, lane = tid & 63, col = lane & 31, hi = lane >> 5;
    const bf16_t* PROJ = (const bf16_t*)(p.ws() + WS_PROJ); const bf16_t* VT = (const bf16_t*)(p.ws() + WS_VT); bf16_t* MIX = (bf16_t*)(p.ws() + WS_MIX);
    const float* LOGF = p.out() + OFF_LP + (size_t)l * MP * 6;
    const int q0 = qi == 0 ? 0 : 16 + 256 * (qi - 1), nrows = qi == 0 ? 16 : 256, kend = q0 + nrows, nt = (kend + 63) >> 6;
    const int qw0 = q0 + 32 * wid; const bool wact = 32 * wid < nrows; const int qrow = qw0 + col;
    const size_t rowbase = (size_t)b * TP;
    bf16x8 qf[4];
    { const bf16_t* qp = PROJ + (rowbase + (qrow < TP ? qrow : TP - 1)) * NPROJ + h * 64 + 8 * hi;
#pragma unroll
      for (int ks = 0; ks < 4; ++ks) qf[ks] = *(const bf16x8*)(qp + 16 * ks); }
    const int lr = tid >> 3, lseg = tid & 7;
    const bf16_t* kg = PROJ + CK_ + h * 64 + lseg * 8;
    const int vkey = tid & 63, vds = tid >> 6;
    const bf16_t* vg = PROJ + CV_ + h * 64 + vds * 8;
    const int vpos = (vkey & ~15) + 8 * ((vkey >> 2) & 1) + 4 * ((vkey >> 3) & 1) + (vkey & 3);
    float carry = 0.f; u32x4 kreg, vreg; float lfv = 0.f;
#define ATT_GLOAD(K0) do { const int key_ = (K0) + lr; kreg = *(const u32x4*)(kg + (rowbase + (key_ < TP ? key_ : TP - 1)) * NPROJ); { const int vk_ = (K0) + vkey; vreg = *(const u32x4*)(vg + (rowbase + (vk_ < TP ? vk_ : TP - 1)) * NPROJ); } \
        if (wid == 0) { const int kk_ = (K0) + lane; lfv = kk_ < TP ? LOGF[(rowbase + kk_) * 6 + h] : 0.f; } } while (0)
#define ATT_LSTORE(S) do { unsigned char* B_ = shm + (S) * ABUF; *(u32x4*)(B_ + lr * 144 + lseg * 16) = kreg; { bf16_t* v_ = (bf16_t*)(B_ + 9216) + (vds * 8) * 72 + vpos; v_[0] = (bf16_t)(vreg.x & 0xffffu); v_[72] = (bf16_t)(vreg.x >> 16); v_[144] = (bf16_t)(vreg.y & 0xffffu); v_[216] = (bf16_t)(vreg.y >> 16); \
          v_[288] = (bf16_t)(vreg.z & 0xffffu); v_[360] = (bf16_t)(vreg.z >> 16); v_[432] = (bf16_t)(vreg.w & 0xffffu); v_[504] = (bf16_t)(vreg.w >> 16); } \
        if (wid == 0) { float v_ = wave_scan_incl(lfv, lane) + carry; ((float*)(B_ + 18432))[lane] = -v_ * LOG2E; carry = __shfl(v_, 63); } } while (0)
    ATT_GLOAD(0); ATT_LSTORE(0); __syncthreads();
    f32x16 o0, o1;
#pragma unroll
    for (int i = 0; i < 16; ++i) { o0[i] = 0.f; o1[i] = 0.f; }
    float m = -1e30f, lsum = 0.f;
    for (int t = 0; t < nt; ++t) {
        const int k0 = t * 64; const bool more = t + 1 < nt;
        if (more) ATT_GLOAD(k0 + 64);
        if (wact && k0 <= qw0 + 31) {
            const unsigned char* B = shm + (t & 1) * ABUF;
            f32x16 s0, s1;
            const float* cbp = (const float*)(B + 18432);
#pragma unroll
            for (int g = 0; g < 4; ++g) { const f32x4 c0 = *(const f32x4*)(cbp + 8 * g + 4 * hi), c1 = *(const f32x4*)(cbp + 32 + 8 * g + 4 * hi);
#pragma unroll
                for (int j = 0; j < 4; ++j) { s0[4 * g + j] = c0[j]; s1[4 * g + j] = c1[j]; } }
#pragma unroll
            for (int ks = 0; ks < 4; ++ks) {
                const bf16x8 a0 = *(const bf16x8*)(B + col * 144 + (16 * ks + 8 * hi) * 2), a1 = *(const bf16x8*)(B + (32 + col) * 144 + (16 * ks + 8 * hi) * 2);
                s0 = MFMA32(a0, qf[ks], s0); s1 = MFMA32(a1, qf[ks], s1);
            }
            if (k0 + 63 > qw0) {
#pragma unroll
                for (int i = 0; i < 16; ++i) { const int key = k0 + crow(i, hi); if (key > qrow) s0[i] = -INFINITY; if (key + 32 > qrow) s1[i] = -INFINITY; }
            }
            float mx = fmaxf(s0[0], s0[1]);
#pragma unroll
            for (int i = 2; i < 16; i += 2) mx = fmaxf(fmaxf(mx, s0[i]), s0[i + 1]);
#pragma unroll
            for (int i = 0; i < 16; i += 2) mx = fmaxf(fmaxf(mx, s1[i]), s1[i + 1]);
            mx = fmaxf(mx, __shfl_xor(mx, 32));
            const float mn = fmaxf(m, mx), alpha = ex2(m - mn); m = mn;
            typedef float f32x2_t __attribute__((ext_vector_type(2)));
            const f32x2_t mn2 = {mn, mn}; f32x2_t ps2 = {0.f, 0.f};
#pragma unroll
            for (int i = 0; i < 16; i += 2) {
                f32x2_t a = (f32x2_t){s0[i], s0[i + 1]} - mn2, b2 = (f32x2_t){s1[i], s1[i + 1]} - mn2;
                a.x = ex2(a.x); a.y = ex2(a.y); b2.x = ex2(b2.x); b2.y = ex2(b2.y);
                s0[i] = a.x; s0[i + 1] = a.y; s1[i] = b2.x; s1[i + 1] = b2.y; ps2 += a + b2;
            }
            const float ps = ps2.x + ps2.y;
            lsum = lsum * alpha + ps;
#pragma unroll
            for (int i = 0; i < 16; ++i) { o0[i] *= alpha; o1[i] *= alpha; }
#pragma unroll
            for (int kb = 0; kb < 2; ++kb)
#pragma unroll
                for (int s = 0; s < 2; ++s) {
                    const bf16x8 pf = kb == 0 ? pack8(s0[8 * s], s0[8 * s + 1], s0[8 * s + 2], s0[8 * s + 3], s0[8 * s + 4], s0[8 * s + 5], s0[8 * s + 6], s0[8 * s + 7])
                                              : pack8(s1[8 * s], s1[8 * s + 1], s1[8 * s + 2], s1[8 * s + 3], s1[8 * s + 4], s1[8 * s + 5], s1[8 * s + 6], s1[8 * s + 7]);
                    const unsigned char* vb = B + 9216 + (kb * 32 + 16 * s + 8 * hi) * 2;
                    const bf16x8 a0 = *(const bf16x8*)(vb + col * 144), a1 = *(const bf16x8*)(vb + (32 + col) * 144);
                    o0 = MFMA32(a0, pf, o0); o1 = MFMA32(a1, pf, o1);
                }
        }
        if (more) ATT_LSTORE((t + 1) & 1);
        __syncthreads();
    }
#undef ATT_GLOAD
#undef ATT_LSTORE
    if (wact) {
        const float lt = lsum + __shfl_xor(lsum, 32); const float inv = 1.f / lt;
        if (qrow < kend) { bf16_t* op = MIX + (rowbase + qrow) * 1024 + h * 64;
#pragma unroll
            for (int g = 0; g < 4; ++g) {
                u32x2 w0 = {pack2(o0[4 * g] * inv, o0[4 * g + 1] * inv), pack2(o0[4 * g + 2] * inv, o0[4 * g + 3] * inv)};
                u32x2 w1 = {pack2(o1[4 * g] * inv, o1[4 * g + 1] * inv), pack2(o1[4 * g + 2] * inv, o1[4 * g + 3] * inv)};
                *(u32x2*)(op + 8 * g + 4 * hi) = w0; *(u32x2*)(op + 32 + 8 * g + 4 * hi) = w1;
            } }
    }
}

DI bool attn_prompt_fast(const PV& p, int l, int b, int h, int qi, unsigned char* shm) {
    int tid_ = threadIdx.x; asm volatile("" : "+v"(tid_)); const int tid = tid_, wid = tid >> 6, lane = tid & 63, col = lane & 31, hi = lane >> 5;
    const bf16_t* PROJ = (const bf16_t*)(p.ws() + WS_PROJ); const bf16_t* VT = (const bf16_t*)(p.ws() + WS_VT); bf16_t* MIX = (bf16_t*)(p.ws() + WS_MIX);
    const float* LOGF = p.out() + OFF_LP + (size_t)l * MP * 6;
    int* oflag = (int*)(shm + 131072 + 32);
    const int q0 = qi == 0 ? 0 : 16 + 256 * (qi - 1), nrows = qi == 0 ? 16 : 256, kend = q0 + nrows, nt = (kend + 63) >> 6;
    const int qw0 = q0 + 32 * wid; const bool wact = 32 * wid < nrows; const int qrow = qw0 + col;
    const size_t rowbase = (size_t)b * TP;
    if (tid == 0) *oflag = 0;
    bf16x8 qf[4];
    { const bf16_t* qp = PROJ + (rowbase + (qrow < TP ? qrow : TP - 1)) * NPROJ + h * 64 + 8 * hi;
#pragma unroll
      for (int ks = 0; ks < 4; ++ks) qf[ks] = *(const bf16x8*)(qp + 16 * ks); }
    const int lr = tid >> 3, lseg = tid & 7;
    const bf16_t* kg = PROJ + CK_ + h * 64 + lseg * 8;
    const int vkey = tid & 63, vds = tid >> 6;
    const bf16_t* vg = PROJ + CV_ + h * 64 + vds * 8;
    const int vpos = (vkey & ~15) + 8 * ((vkey >> 2) & 1) + 4 * ((vkey >> 3) & 1) + (vkey & 3);
    float carry = 0.f; u32x4 kreg, vreg; float lfv = 0.f;
#define ATF_GLOAD(K0) do { const int key_ = (K0) + lr; kreg = *(const u32x4*)(kg + (rowbase + (key_ < TP ? key_ : TP - 1)) * NPROJ); { const int vk_ = (K0) + vkey; vreg = *(const u32x4*)(vg + (rowbase + (vk_ < TP ? vk_ : TP - 1)) * NPROJ); } \
        if (wid == 0) { const int kk_ = (K0) + lane; lfv = kk_ < TP ? LOGF[(rowbase + kk_) * 6 + h] : 0.f; } } while (0)
#define ATF_LSTORE(S) do { unsigned char* B_ = shm + (S) * ABUF; *(u32x4*)(B_ + lr * 144 + lseg * 16) = kreg; { bf16_t* v_ = (bf16_t*)(B_ + 9216) + (vds * 8) * 72 + vpos; v_[0] = (bf16_t)(vreg.x & 0xffffu); v_[72] = (bf16_t)(vreg.x >> 16); v_[144] = (bf16_t)(vreg.y & 0xffffu); v_[216] = (bf16_t)(vreg.y >> 16); \
          v_[288] = (bf16_t)(vreg.z & 0xffffu); v_[360] = (bf16_t)(vreg.z >> 16); v_[432] = (bf16_t)(vreg.w & 0xffffu); v_[504] = (bf16_t)(vreg.w >> 16); } \
        if (wid == 0) { const float in_ = wave_scan_incl(lfv, lane); const float tot_ = __shfl(in_, 63); ((float*)(B_ + 18432))[lane] = (carry + (tot_ - in_)) * LOG2E; carry += tot_; } } while (0)
    ATF_GLOAD(64 * (nt - 1)); ATF_LSTORE((nt - 1) & 1); __syncthreads();
    f32x16 o0, o1;
#pragma unroll
    for (int i = 0; i < 16; ++i) { o0[i] = 0.f; o1[i] = 0.f; }
    float mref = 0.f, l0 = 0.f, l1 = 0.f, l2 = 0.f, l3 = 0.f;
    for (int t = nt - 1; t >= 0; --t) {
        const int k0 = t * 64; const bool more = t > 0;
        if (more) ATF_GLOAD(k0 - 64);
        if (wact && k0 <= qw0 + 31) {
            const unsigned char* B = shm + (t & 1) * ABUF;
            const float* cbp = (const float*)(B + 18432);
            const bool diag = k0 + 63 > qw0;
            if (diag) { const int d = qrow - k0; if (d >= 0 && d < 64) mref = cbp[d]; }
            f32x16 s0, s1;
#pragma unroll
            for (int g = 0; g < 4; ++g) { const f32x4 c0 = *(const f32x4*)(cbp + 8 * g + 4 * hi), c1 = *(const f32x4*)(cbp + 32 + 8 * g + 4 * hi);
#pragma unroll
                for (int j = 0; j < 4; ++j) { s0[4 * g + j] = c0[j] - mref; s1[4 * g + j] = c1[j] - mref; } }
#pragma unroll
            for (int ks = 0; ks < 4; ++ks) {
                const bf16x8 a0 = *(const bf16x8*)(B + col * 144 + (16 * ks + 8 * hi) * 2), a1 = *(const bf16x8*)(B + (32 + col) * 144 + (16 * ks + 8 * hi) * 2);
                s0 = MFMA32(a0, qf[ks], s0); s1 = MFMA32(a1, qf[ks], s1);
            }
            if (diag) {
#pragma unroll
                for (int i = 0; i < 16; ++i) { const int key = k0 + crow(i, hi); if (key > qrow) s0[i] = -INFINITY; if (key + 32 > qrow) s1[i] = -INFINITY; }
            }
#pragma unroll
            for (int i = 0; i < 16; ++i) { s0[i] = ex2(s0[i]); s1[i] = ex2(s1[i]); }
#pragma unroll
            for (int i = 0; i < 16; i += 2) { l0 += s0[i]; l1 += s1[i + 1]; l2 += s1[i]; l3 += s0[i + 1]; }
#pragma unroll
            for (int kb = 0; kb < 2; ++kb)
#pragma unroll
                for (int s = 0; s < 2; ++s) {
                    const bf16x8 pf = kb == 0 ? pack8(s0[8 * s], s0[8 * s + 1], s0[8 * s + 2], s0[8 * s + 3], s0[8 * s + 4], s0[8 * s + 5], s0[8 * s + 6], s0[8 * s + 7])
                                              : pack8(s1[8 * s], s1[8 * s + 1], s1[8 * s + 2], s1[8 * s + 3], s1[8 * s + 4], s1[8 * s + 5], s1[8 * s + 6], s1[8 * s + 7]);
                    const unsigned char* vb = B + 9216 + (kb * 32 + 16 * s + 8 * hi) * 2;
                    const bf16x8 a0 = *(const bf16x8*)(vb + col * 144), a1 = *(const bf16x8*)(vb + (32 + col) * 144);
                    o0 = MFMA32(a0, pf, o0); o1 = MFMA32(a1, pf, o1);
                }
        }
        if (more) ATF_LSTORE((t - 1) & 1);
        __syncthreads();
    }
#undef ATF_GLOAD
#undef ATF_LSTORE
    if (wact) {
        const float lsum = (l0 + l1) + (l2 + l3);
        const float lt = lsum + __shfl_xor(lsum, 32); const float inv = 1.f / lt;
        if (qrow < kend) {
            if (!(lt < 3.0e38f) || !(lt > 0.f)) *oflag = 1;
            bf16_t* op = MIX + (rowbase + qrow) * 1024 + h * 64;
#pragma unroll
            for (int g = 0; g < 4; ++g) {
                u32x2 w0 = {pack2(o0[4 * g] * inv, o0[4 * g + 1] * inv), pack2(o0[4 * g + 2] * inv, o0[4 * g + 3] * inv)};
                u32x2 w1 = {pack2(o1[4 * g] * inv, o1[4 * g + 1] * inv), pack2(o1[4 * g + 2] * inv, o1[4 * g + 3] * inv)};
                *(u32x2*)(op + 8 * g + 4 * hi) = w0; *(u32x2*)(op + 32 + 8 * g + 4 * hi) = w1;
            } }
    }
    __syncthreads();
    return *oflag != 0;
}

DI void attn_sample(const PV& p, int l, int b, int h, unsigned char* shm) {
    int tid_ = threadIdx.x; asm volatile("" : "+v"(tid_)); const int tid = tid_, wid = tid >> 6, lane = tid & 63, col = lane & 31, hi = lane >> 5;
    const bf16_t* PROJ = (const bf16_t*)(p.ws() + WS_PROJ); bf16_t* MIX = (bf16_t*)(p.ws() + WS_MIX);
    float* cbs = (float*)shm; float* OW = (float*)(shm + 4352); float* ML = (float*)(shm + 4352 + 65536);
    const size_t cbase = (size_t)(l * DB + b) * PAST; const size_t rbase = (size_t)MP + b * 32;
    if (wid == 0) {
        const float* cl = p.cache_logf() + cbase * 6 + h; const float* lfn = p.out() + OFF_LS + ((size_t)l * MS + b * 32) * 6 + h;
        float v[17];
#pragma unroll
        for (int i = 0; i < 17; ++i) { const int idx = i * 64 + lane; v[i] = idx < PAST ? cl[(size_t)idx * 6] : (idx < PAST + DS ? lfn[(size_t)(idx - PAST) * 6] : 0.f); }
        float carry = 0.f;
#pragma unroll
        for (int i = 0; i < 17; ++i) { const int idx = i * 64 + lane; const float s = wave_scan_incl(v[i], lane) + carry; if (idx < PAST + DS) cbs[idx] = -s * LOG2E; carry = __shfl(s, 63); }
    }
    __syncthreads();
    bf16x8 qf[4];
    { const bf16_t* qp = PROJ + (rbase + col) * NPROJ + h * 64 + 8 * hi;
#pragma unroll
      for (int ks = 0; ks < 4; ++ks) qf[ks] = *(const bf16x8*)(qp + 16 * ks); }
    f32x16 o0, o1;
#pragma unroll
    for (int i = 0; i < 16; ++i) { o0[i] = 0.f; o1[i] = 0.f; }
    float m = -1e30f, lsum = 0.f;
    for (int tile = wid; tile < 33; tile += 8) {
        f32x16 s;
#pragma unroll
        for (int i = 0; i < 16; ++i) s[i] = 0.f;
        if (tile < 32) {
            const float* kp = p.cache_k() + (cbase + tile * 32 + col) * 384 + h * 64 + 8 * hi;
#pragma unroll
            for (int ks = 0; ks < 4; ++ks) { const f32x4 x0 = *(const f32x4*)(kp + 16 * ks), x1 = *(const f32x4*)(kp + 16 * ks + 4);
                s = MFMA32(pack8(x0[0], x0[1], x0[2], x0[3], x1[0], x1[1], x1[2], x1[3]), qf[ks], s); }
        } else {
            const bf16_t* kp = PROJ + (rbase + col) * NPROJ + CK_ + h * 64 + 8 * hi;
#pragma unroll
            for (int ks = 0; ks < 4; ++ks) s = MFMA32(*(const bf16x8*)(kp + 16 * ks), qf[ks], s);
        }
#pragma unroll
        for (int g = 0; g < 4; ++g) { const f32x4 c0 = *(const f32x4*)(cbs + tile * 32 + 8 * g + 4 * hi);
#pragma unroll
            for (int j = 0; j < 4; ++j) s[4 * g + j] += c0[j]; }
        if (tile == 32) {
#pragma unroll
            for (int i = 0; i < 16; ++i) if (crow(i, hi) > col) s[i] = -INFINITY;
        }
        float mx = s[0];
#pragma unroll
        for (int i = 1; i < 16; ++i) mx = fmaxf(mx, s[i]);
        mx = fmaxf(mx, __shfl_xor(mx, 32));
        const float mn = fmaxf(m, mx), alpha = ex2(m - mn); m = mn;
        float ps = 0.f;
#pragma unroll
        for (int i = 0; i < 16; ++i) { s[i] = ex2(s[i] - mn); ps += s[i]; }
        lsum = lsum * alpha + ps;
#pragma unroll
        for (int i = 0; i < 16; ++i) { o0[i] *= alpha; o1[i] *= alpha; }
#pragma unroll
        for (int ss = 0; ss < 2; ++ss) {
            const bf16x8 pf = pack8(s[8 * ss], s[8 * ss + 1], s[8 * ss + 2], s[8 * ss + 3], s[8 * ss + 4], s[8 * ss + 5], s[8 * ss + 6], s[8 * ss + 7]);
            bf16x8 a0, a1;
            if (tile < 32) {
                const float* vp = p.cache_v() + (cbase + tile * 32 + 16 * ss + 4 * hi) * 384 + h * 64 + col;
                a0 = pack8(vp[0], vp[384], vp[2 * 384], vp[3 * 384], vp[8 * 384], vp[9 * 384], vp[10 * 384], vp[11 * 384]);
                a1 = pack8(vp[32], vp[384 + 32], vp[2 * 384 + 32], vp[3 * 384 + 32], vp[8 * 384 + 32], vp[9 * 384 + 32], vp[10 * 384 + 32], vp[11 * 384 + 32]);
            } else {
                const bf16_t* vp = PROJ + (rbase + 16 * ss + 4 * hi) * NPROJ + CV_ + h * 64 + col;
                u32x4 w0 = {(unsigned)vp[0] | ((unsigned)vp[NPROJ] << 16), (unsigned)vp[2 * NPROJ] | ((unsigned)vp[3 * NPROJ] << 16),
                            (unsigned)vp[8 * NPROJ] | ((unsigned)vp[9 * NPROJ] << 16), (unsigned)vp[10 * NPROJ] | ((unsigned)vp[11 * NPROJ] << 16)};
                u32x4 w1 = {(unsigned)vp[32] | ((unsigned)vp[NPROJ + 32] << 16), (unsigned)vp[2 * NPROJ + 32] | ((unsigned)vp[3 * NPROJ + 32] << 16),
                            (unsigned)vp[8 * NPROJ + 32] | ((unsigned)vp[9 * NPROJ + 32] << 16), (unsigned)vp[10 * NPROJ + 32] | ((unsigned)vp[11 * NPROJ + 32] << 16)};
                a0 = __builtin_bit_cast(bf16x8, w0); a1 = __builtin_bit_cast(bf16x8, w1);
            }
            o0 = MFMA32(a0, pf, o0); o1 = MFMA32(a1, pf, o1);
        }
    }
    { const float lt = lsum + __shfl_xor(lsum, 32); float* Ow = OW + wid * 2048;
#pragma unroll
      for (int i = 0; i < 16; ++i) { Ow[crow(i, hi) * 32 + col] = o0[i]; Ow[(32 + crow(i, hi)) * 32 + col] = o1[i]; }
      if (hi == 0) { ML[(wid * 32 + col) * 2] = m; ML[(wid * 32 + col) * 2 + 1] = lt; } }
    __syncthreads();
    { const int q = tid & 31, dg = tid >> 5; float M = -1e30f;
#pragma unroll
      for (int w = 0; w < 8; ++w) M = fmaxf(M, ML[(w * 32 + q) * 2]);
      float L = 0.f, a0 = 0.f, a1 = 0.f, a2 = 0.f, a3 = 0.f;
#pragma unroll
      for (int w = 0; w < 8; ++w) { const float f = ex2(ML[(w * 32 + q) * 2] - M); L += ML[(w * 32 + q) * 2 + 1] * f; const float* Ow = OW + w * 2048 + (4 * dg) * 32 + q;
          a0 += Ow[0] * f; a1 += Ow[32] * f; a2 += Ow[64] * f; a3 += Ow[96] * f; }
      const float inv = 1.f / L; u32x2 w = {pack2(a0 * inv, a1 * inv), pack2(a2 * inv, a3 * inv)};
      *(u32x2*)(MIX + (rbase + q) * 1024 + h * 64 + 4 * dg) = w; }
}

DI int swz72(int row, int s) { return row * 72 + ((((s >> 3) ^ ((row >> 2) & 7)) << 3) | (s & 7)); }
constexpr int L_XT = 0, L_BM = 55296, L_BT = 73728, L_CM = 92160, L_DTS = 110592, L_ACS = 112128;
DI void ssd_a(const PV& p, int l, int grp, int b, int c, unsigned char* shm) {
    int tid_ = threadIdx.x; asm volatile("" : "+v"(tid_)); const int tid = tid_, wid = tid >> 6, lane = tid & 63, col = lane & 31, hi = lane >> 5;
    const bf16_t* PROJ = (const bf16_t*)(p.ws() + WS_PROJ); const float* DT = (const float*)(p.ws() + WS_DT);
    float* Y32 = (float*)(p.ws() + WS_Y32); bf16_t* CC = (bf16_t*)(p.ws() + WS_CC); float* ACSG = (float*)(p.ws() + WS_ACS); float* ST = (float*)(p.ws() + WS_ST);
    bf16_t* XT = (bf16_t*)(shm + L_XT); bf16_t* BM = (bf16_t*)(shm + L_BM); bf16_t* BT = (bf16_t*)(shm + L_BT); bf16_t* CM = (bf16_t*)(shm + L_CM);
    float* DTS = (float*)(shm + L_DTS); float* ACSL = (float*)(shm + L_ACS);
    const int t0 = grp == 0 ? 64 * c - 48 : 0, tlim = grp == 0 ? TP : DS;
    const size_t rbase = grp == 0 ? (size_t)b * TP : (size_t)MP + b * 32;
    if (wid < 6) {
        const int t = t0 + lane; const bool valid = t >= 0 && t < tlim;
        const float dt = valid ? DT[(rbase + t) * 8 + wid] : 0.f; const float a = -expf(p.a_log()[l * 6 + wid]);
        const float acs = wave_scan_incl(dt * a, lane);
        DTS[wid * 64 + lane] = dt; ACSL[wid * 64 + lane] = acs; if (valid) ACSG[(rbase + t) * 8 + wid] = acs;
    }
    const float* cw = p.conv_w() + (size_t)l * 4 * 640; const float* cbias = p.conv_b() + (size_t)l * 640;
    if (tid < 480) {
        const int ch = 4 * (tid % 160), rg = tid / 160, sb = rg * 22, se = sb + 22 < 64 ? sb + 22 : 64;
        const f32x4 w0 = *(const f32x4*)(cw + ch), w1 = *(const f32x4*)(cw + 640 + ch), w2 = *(const f32x4*)(cw + 1280 + ch), w3 = *(const f32x4*)(cw + 1920 + ch), bias4 = *(const f32x4*)(cbias + ch);
        u32x2 raw[25]; f32x4 pre[3];
#pragma unroll
        for (int i = 0; i < 25; ++i) { const int tt = t0 + sb - 3 + i; raw[i] = (u32x2){0u, 0u};
            if (tt >= 0 && tt < tlim && sb - 3 + i < 64) raw[i] = *(const u32x2*)(PROJ + (rbase + tt) * NPROJ + CX_ + ch); }
#pragma unroll
        for (int i = 0; i < 3; ++i) { const int tt = t0 + sb - 3 + i; pre[i] = (f32x4){0.f, 0.f, 0.f, 0.f};
            if (tt < 0 && grp == 1) pre[i] = *(const f32x4*)(p.state_conv() + ((size_t)(l * DB + b) * 3 + 3 + tt) * 640 + ch); }
        f32x4 xw[25];
#pragma unroll
        for (int i = 0; i < 25; ++i) { xw[i] = (f32x4){bf_lo(raw[i].x), bf_hi(raw[i].x), bf_lo(raw[i].y), bf_hi(raw[i].y)}; if (i < 3) xw[i] += pre[i]; }
#pragma unroll
        for (int r = 0; r < 22; ++r) {
            const int s = sb + r;
            if (s < se) {
                const int t = t0 + s; const bool valid = t >= 0 && t < tlim;
                const f32x4 a = bias4 + xw[r] * w0 + xw[r + 1] * w1 + xw[r + 2] * w2 + xw[r + 3] * w3;
                f32x4 v = {siluf(a[0]), siluf(a[1]), siluf(a[2]), siluf(a[3])};
                if (!valid) v = (f32x4){0.f, 0.f, 0.f, 0.f};
                if (ch < 384) { const int hh = ch >> 6, pp = ch & 63; bf16_t* d = XT + hh * 64 * 72 + swz72(pp, s);
                    d[0] = f2bf(v[0]); d[72] = f2bf(v[1]); d[144] = f2bf(v[2]); d[216] = f2bf(v[3]); }
                else if (ch < 512) { const int g = (ch - 384) >> 6, n = (ch - 384) & 63; u32x2 w = {pack2(v[0], v[1]), pack2(v[2], v[3])};
                    *(u32x2*)(BM + (g * 64 + s) * 72 + n) = w; bf16_t* d = BT + g * 64 * 72 + swz72(n, s);
                    d[0] = (bf16_t)(w.x & 0xffffu); d[72] = (bf16_t)(w.x >> 16); d[144] = (bf16_t)(w.y & 0xffffu); d[216] = (bf16_t)(w.y >> 16); }
                else { const int g = (ch - 512) >> 6, n = (ch - 512) & 63; u32x2 w = {pack2(v[0], v[1]), pack2(v[2], v[3])};
                    *(u32x2*)(CM + (g * 64 + s) * 72 + n) = w; if (valid) *(u32x2*)(CC + (rbase + t) * 128 + (ch - 512)) = w; }
            }
        }
    }
    __syncthreads();
    if (wid < 6) {
        const int h = wid, g = h / 3; const float Dh = p.d_skip()[l * 6 + h];
        const float* acsl = ACSL + h * 64; const float* dts = DTS + h * 64;
        const float acsq0 = acsl[col], acsq1 = acsl[32 + col], acs63 = acsl[63];
        const bf16_t* xt = XT + h * 64 * 72; const bf16_t* bm = BM + g * 64 * 72; const bf16_t* bt = BT + g * 64 * 72; const bf16_t* cm = CM + g * 64 * 72;
        f32x16 g00, g01, g11;
#pragma unroll
        for (int i = 0; i < 16; ++i) { g00[i] = 0.f; g01[i] = 0.f; g11[i] = 0.f; }
#pragma unroll
        for (int ks = 0; ks < 4; ++ks) {
            const int ko = 16 * ks + 8 * hi;
            const bf16x8 bs0 = *(const bf16x8*)(bm + col * 72 + ko), bs1 = *(const bf16x8*)(bm + (32 + col) * 72 + ko);
            const bf16x8 cq0 = *(const bf16x8*)(cm + col * 72 + ko), cq1 = *(const bf16x8*)(cm + (32 + col) * 72 + ko);
            g00 = MFMA32(bs0, cq0, g00); g01 = MFMA32(bs0, cq1, g01); g11 = MFMA32(bs1, cq1, g11);
        }
#pragma unroll
        for (int gq = 0; gq < 4; ++gq) {
            const f32x4 as0 = *(const f32x4*)(acsl + 8 * gq + 4 * hi), as1 = *(const f32x4*)(acsl + 32 + 8 * gq + 4 * hi);
            const f32x4 ds0 = *(const f32x4*)(dts + 8 * gq + 4 * hi), ds1 = *(const f32x4*)(dts + 32 + 8 * gq + 4 * hi);
#pragma unroll
            for (int j = 0; j < 4; ++j) { const int i = 4 * gq + j, s = 8 * gq + 4 * hi + j;
                g00[i] = s <= col ? g00[i] * __expf(acsq0 - as0[j]) * ds0[j] + (s == col ? Dh : 0.f) : 0.f;
                g01[i] = g01[i] * __expf(acsq1 - as0[j]) * ds0[j];
                g11[i] = s <= col ? g11[i] * __expf(acsq1 - as1[j]) * ds1[j] + (s == col ? Dh : 0.f) : 0.f; }
        }
        f32x16 y00, y10, y01, y11;
#pragma unroll
        for (int i = 0; i < 16; ++i) { y00[i] = 0.f; y10[i] = 0.f; y01[i] = 0.f; y11[i] = 0.f; }
#pragma unroll
        for (int ss = 0; ss < 2; ++ss) {
            const int so = 16 * ss + 4 * hi;
            const bf16x8 xa0 = cat8(*(const u32x2*)(xt + swz72(col, so)), *(const u32x2*)(xt + swz72(col, so + 8)));
            const bf16x8 xa1 = cat8(*(const u32x2*)(xt + swz72(32 + col, so)), *(const u32x2*)(xt + swz72(32 + col, so + 8)));
            const bf16x8 xb0 = cat8(*(const u32x2*)(xt + swz72(col, 32 + so)), *(const u32x2*)(xt + swz72(col, 32 + so + 8)));
            const bf16x8 xb1 = cat8(*(const u32x2*)(xt + swz72(32 + col, 32 + so)), *(const u32x2*)(xt + swz72(32 + col, 32 + so + 8)));
            const bf16x8 p00 = pack8(g00[8 * ss], g00[8 * ss + 1], g00[8 * ss + 2], g00[8 * ss + 3], g00[8 * ss + 4], g00[8 * ss + 5], g00[8 * ss + 6], g00[8 * ss + 7]);
            const bf16x8 p01 = pack8(g01[8 * ss], g01[8 * ss + 1], g01[8 * ss + 2], g01[8 * ss + 3], g01[8 * ss + 4], g01[8 * ss + 5], g01[8 * ss + 6], g01[8 * ss + 7]);
            const bf16x8 p11 = pack8(g11[8 * ss], g11[8 * ss + 1], g11[8 * ss + 2], g11[8 * ss + 3], g11[8 * ss + 4], g11[8 * ss + 5], g11[8 * ss + 6], g11[8 * ss + 7]);
            y00 = MFMA32(xa0, p00, y00); y10 = MFMA32(xa1, p00, y10);
            y01 = MFMA32(xa0, p01, y01); y11 = MFMA32(xa1, p01, y11);
            y01 = MFMA32(xb0, p11, y01); y11 = MFMA32(xb1, p11, y11);
        }
        {
            const int tq0 = t0 + col, tq1 = t0 + 32 + col;
            if (tq0 >= 0 && tq0 < tlim) { float* yp = Y32 + (rbase + tq0) * 384 + h * 64;
#pragma unroll
                for (int gq = 0; gq < 4; ++gq) { *(f32x4*)(yp + 8 * gq + 4 * hi) = (f32x4){y00[4 * gq], y00[4 * gq + 1], y00[4 * gq + 2], y00[4 * gq + 3]};
                    *(f32x4*)(yp + 32 + 8 * gq + 4 * hi) = (f32x4){y10[4 * gq], y10[4 * gq + 1], y10[4 * gq + 2], y10[4 * gq + 3]}; } }
            if (tq1 >= 0 && tq1 < tlim) { float* yp = Y32 + (rbase + tq1) * 384 + h * 64;
#pragma unroll
                for (int gq = 0; gq < 4; ++gq) { *(f32x4*)(yp + 8 * gq + 4 * hi) = (f32x4){y01[4 * gq], y01[4 * gq + 1], y01[4 * gq + 2], y01[4 * gq + 3]};
                    *(f32x4*)(yp + 32 + 8 * gq + 4 * hi) = (f32x4){y11[4 * gq], y11[4 * gq + 1], y11[4 * gq + 2], y11[4 * gq + 3]}; } }
        }
        f32x16 c00, c01, c10, c11;
#pragma unroll
        for (int i = 0; i < 16; ++i) { c00[i] = 0.f; c01[i] = 0.f; c10[i] = 0.f; c11[i] = 0.f; }
#pragma unroll
        for (int ks = 0; ks < 4; ++ks) {
            const int ko = 16 * ks + 8 * hi;
            const bf16x8 xa0 = *(const bf16x8*)(xt + swz72(col, ko)), xa1 = *(const bf16x8*)(xt + swz72(32 + col, ko));
            const f32x4 wa = *(const f32x4*)(acsl + ko), wb = *(const f32x4*)(acsl + ko + 4), da = *(const f32x4*)(dts + ko), db_ = *(const f32x4*)(dts + ko + 4);
            float w3[8];
#pragma unroll
            for (int j = 0; j < 4; ++j) { w3[j] = da[j] * __expf(acs63 - wa[j]); w3[4 + j] = db_[j] * __expf(acs63 - wb[j]); }
            const u32x4 r0 = *(const u32x4*)(bt + swz72(col, ko)), r1 = *(const u32x4*)(bt + swz72(32 + col, ko));
            const bf16x8 b0 = pack8(bf_lo(r0.x) * w3[0], bf_hi(r0.x) * w3[1], bf_lo(r0.y) * w3[2], bf_hi(r0.y) * w3[3], bf_lo(r0.z) * w3[4], bf_hi(r0.z) * w3[5], bf_lo(r0.w) * w3[6], bf_hi(r0.w) * w3[7]);
            const bf16x8 b1 = pack8(bf_lo(r1.x) * w3[0], bf_hi(r1.x) * w3[1], bf_lo(r1.y) * w3[2], bf_hi(r1.y) * w3[3], bf_lo(r1.z) * w3[4], bf_hi(r1.z) * w3[5], bf_lo(r1.w) * w3[6], bf_hi(r1.w) * w3[7]);
            c00 = MFMA32(b0, xa0, c00); c01 = MFMA32(b0, xa1, c01); c10 = MFMA32(b1, xa0, c10); c11 = MFMA32(b1, xa1, c11);
        }
        if (grp == 0) { float* sp = ST + ((size_t)(b * NCH + c) * 6 + h) * 4096;
#pragma unroll
            for (int gq = 0; gq < 4; ++gq) { const int n0 = 8 * gq + 4 * hi;
                *(f32x4*)(sp + col * 64 + n0) = (f32x4){c00[4 * gq], c00[4 * gq + 1], c00[4 * gq + 2], c00[4 * gq + 3]};
                *(f32x4*)(sp + (32 + col) * 64 + n0) = (f32x4){c01[4 * gq], c01[4 * gq + 1], c01[4 * gq + 2], c01[4 * gq + 3]};
                *(f32x4*)(sp + col * 64 + 32 + n0) = (f32x4){c10[4 * gq], c10[4 * gq + 1], c10[4 * gq + 2], c10[4 * gq + 3]};
                *(f32x4*)(sp + (32 + col) * 64 + 32 + n0) = (f32x4){c11[4 * gq], c11[4 * gq + 1], c11[4 * gq + 2], c11[4 * gq + 3]}; } }
        else { const size_t so = ((size_t)(l * DB + b) * 6 + h) * 4096; const float* ip = p.state_ssd() + so; float* op = p.out() + OFF_SS + so; const float dec = __expf(acs63);
#pragma unroll
            for (int gq = 0; gq < 4; ++gq) { const int n0 = 8 * gq + 4 * hi;
                *(f32x4*)(op + col * 64 + n0) = *(const f32x4*)(ip + col * 64 + n0) * dec + (f32x4){c00[4 * gq], c00[4 * gq + 1], c00[4 * gq + 2], c00[4 * gq + 3]};
                *(f32x4*)(op + (32 + col) * 64 + n0) = *(const f32x4*)(ip + (32 + col) * 64 + n0) * dec + (f32x4){c01[4 * gq], c01[4 * gq + 1], c01[4 * gq + 2], c01[4 * gq + 3]};
                *(f32x4*)(op + col * 64 + 32 + n0) = *(const f32x4*)(ip + col * 64 + 32 + n0) * dec + (f32x4){c10[4 * gq], c10[4 * gq + 1], c10[4 * gq + 2], c10[4 * gq + 3]};
                *(f32x4*)(op + (32 + col) * 64 + 32 + n0) = *(const f32x4*)(ip + (32 + col) * 64 + 32 + n0) * dec + (f32x4){c11[4 * gq], c11[4 * gq + 1], c11[4 * gq + 2], c11[4 * gq + 3]}; } }
    }
}

DI void ssd_scan(const PV& p, int l) {
    float* ST = (float*)(p.ws() + WS_ST); const float* ACSG = (const float*)(p.ws() + WS_ACS);
    int tid_ = threadIdx.x; asm volatile("" : "+v"(tid_));
    for (int e = blockIdx.x * 512 + tid_; e < NB * 6 * 4096; e += gridDim.x * 512) {
        const int bh = e >> 12, pn = e & 4095, b = bh / 6, h = bh - b * 6;
        float* sp = ST + ((size_t)b * NCH * 6 + h) * 4096 + pn;
        const float* ap = ACSG + ((size_t)b * TP + 15) * 8 + h;
        float cs[NCH], dec[NCH];
#pragma unroll
        for (int j = 0; j < NCH; ++j) { cs[j] = sp[(size_t)j * 24576]; dec[j] = ap[(size_t)j * 512]; }
        float state = 0.f;
#pragma unroll
        for (int j = 0; j < NCH; ++j) { sp[(size_t)j * 24576] = state; state = __expf(dec[j]) * state + cs[j]; }
        p.out()[OFF_SP + ((size_t)(l * NB + b) * 6 + h) * 4096 + pn] = state;
    }
}

DI void ssd_c(const PV& p, int l, int grp, int b, int c, unsigned char* shm) {
    int tid_ = threadIdx.x; asm volatile("" : "+v"(tid_)); const int tid = tid_, wid = tid >> 6, lane = tid & 63, col = lane & 31, hi = lane >> 5;
    const bf16_t* PROJ = (const bf16_t*)(p.ws() + WS_PROJ); const float* Y32 = (const float*)(p.ws() + WS_Y32); const bf16_t* CC = (const bf16_t*)(p.ws() + WS_CC);
    const float* ACSG = (const float*)(p.ws() + WS_ACS); const float* ST = (const float*)(p.ws() + WS_ST); bf16_t* MIX = (bf16_t*)(p.ws() + WS_MIX);
    float* SSQ = (float*)shm;
    const int t0 = grp == 0 ? 64 * c - 48 : 0, tlim = grp == 0 ? TP : DS;
    const size_t rbase = grp == 0 ? (size_t)b * TP : (size_t)MP + b * 32;
    f32x16 y[2][2];
    const int h = wid, g = h / 3;
    int tq[2]; bool vq[2]; size_t rq[2];
#pragma unroll
    for (int qb = 0; qb < 2; ++qb) { const int t = t0 + 32 * qb + col; vq[qb] = t >= 0 && t < tlim; tq[qb] = t < 0 ? 0 : (t >= tlim ? tlim - 1 : t); rq[qb] = rbase + tq[qb]; }
    if (wid < 6) {
        const float* prev = grp == 0 ? ST + ((size_t)(b * NCH + c) * 6 + h) * 4096 : p.state_ssd() + ((size_t)(l * DB + b) * 6 + h) * 4096;
        bf16x8 bq[4][2]; f32x4 pa[4][2][2];
#pragma unroll
        for (int ks = 0; ks < 4; ++ks) {
            const int ko = 16 * ks + 8 * hi;
#pragma unroll
            for (int pb = 0; pb < 2; ++pb) { const float* pp = prev + (32 * pb + col) * 64 + ko; pa[ks][pb][0] = *(const f32x4*)pp; pa[ks][pb][1] = *(const f32x4*)(pp + 4); }
#pragma unroll
            for (int qb = 0; qb < 2; ++qb) bq[ks][qb] = *(const bf16x8*)(CC + rq[qb] * 128 + g * 64 + ko);
        }
        f32x4 yd[2][2][4]; u32x2 zw[2][2][4]; float eqv[2];
#pragma unroll
        for (int qb = 0; qb < 2; ++qb) { eqv[qb] = ACSG[rq[qb] * 8 + h];
#pragma unroll
            for (int pb = 0; pb < 2; ++pb)
#pragma unroll
                for (int gq = 0; gq < 4; ++gq) { const int p0 = 32 * pb + 8 * gq + 4 * hi;
                    yd[qb][pb][gq] = *(const f32x4*)(Y32 + rq[qb] * 384 + h * 64 + p0); zw[qb][pb][gq] = *(const u32x2*)(PROJ + rq[qb] * NPROJ + CZ_ + h * 64 + p0); } }
#pragma unroll
        for (int pb = 0; pb < 2; ++pb)
#pragma unroll
            for (int qb = 0; qb < 2; ++qb)
#pragma unroll
                for (int i = 0; i < 16; ++i) y[pb][qb][i] = 0.f;
#pragma unroll
        for (int ks = 0; ks < 4; ++ks) {
            bf16x8 a[2];
#pragma unroll
            for (int pb = 0; pb < 2; ++pb) { const f32x4 x0 = pa[ks][pb][0], x1 = pa[ks][pb][1]; a[pb] = pack8(x0[0], x0[1], x0[2], x0[3], x1[0], x1[1], x1[2], x1[3]); }
#pragma unroll
            for (int pb = 0; pb < 2; ++pb)
#pragma unroll
                for (int qb = 0; qb < 2; ++qb) y[pb][qb] = MFMA32(a[pb], bq[ks][qb], y[pb][qb]);
        }
#pragma unroll
        for (int qb = 0; qb < 2; ++qb) {
            const float eq = __expf(eqv[qb]); float ssq = 0.f;
#pragma unroll
            for (int pb = 0; pb < 2; ++pb)
#pragma unroll
                for (int gq = 0; gq < 4; ++gq) {
                    const f32x4 ydv = yd[qb][pb][gq]; const u32x2 zv = zw[qb][pb][gq];
                    const float z0 = bf_lo(zv.x), z1 = bf_hi(zv.x), z2 = bf_lo(zv.y), z3 = bf_hi(zv.y);
                    const float v0 = (ydv[0] + eq * y[pb][qb][4 * gq]) * siluf(z0), v1 = (ydv[1] + eq * y[pb][qb][4 * gq + 1]) * siluf(z1);
                    const float v2 = (ydv[2] + eq * y[pb][qb][4 * gq + 2]) * siluf(z2), v3 = (ydv[3] + eq * y[pb][qb][4 * gq + 3]) * siluf(z3);
                    y[pb][qb][4 * gq] = v0; y[pb][qb][4 * gq + 1] = v1; y[pb][qb][4 * gq + 2] = v2; y[pb][qb][4 * gq + 3] = v3;
                    ssq += v0 * v0 + v1 * v1 + v2 * v2 + v3 * v3;
                }
            ssq += __shfl_xor(ssq, 32);
            if (hi == 0) SSQ[h * 64 + 32 * qb + col] = ssq;
        }
    }
    __syncthreads();
    if (wid < 6) {
        const float* gn = p.ssd_norm() + (size_t)l * 384 + h * 64;
#pragma unroll
        for (int qb = 0; qb < 2; ++qb) {
            float tot = 0.f;
#pragma unroll
            for (int hh = 0; hh < 6; ++hh) tot += SSQ[hh * 64 + 32 * qb + col];
            const float rs = rsqrtf(tot * (1.f / 384.f) + EPS);
            if (vq[qb]) {
#pragma unroll
                for (int pb = 0; pb < 2; ++pb)
#pragma unroll
                    for (int gq = 0; gq < 4; ++gq) {
                        const int p0 = 32 * pb + 8 * gq + 4 * hi; const f32x4 gg = *(const f32x4*)(gn + p0);
                        u32x2 w = {pack2(y[pb][qb][4 * gq] * rs * gg[0], y[pb][qb][4 * gq + 1] * rs * gg[1]), pack2(y[pb][qb][4 * gq + 2] * rs * gg[2], y[pb][qb][4 * gq + 3] * rs * gg[3])};
                        *(u32x2*)(MIX + rq[qb] * 1024 + 640 + h * 64 + p0) = w;
                    }
            }
        }
    }
}

DI void kv_out_item(const PV& p, int l, int j) {
    int tid_ = threadIdx.x; asm volatile("" : "+v"(tid_)); const int tid = tid_;
    const bf16_t* PROJ = (const bf16_t*)(p.ws() + WS_PROJ); float* o = p.out();
    float* kp = o + OFF_KP + (size_t)l * MP * 384; float* ks = o + OFF_KS + (size_t)l * MS * 384; float* vp = o + OFF_VP + (size_t)l * MP * 384; float* vs = o + OFF_VS + (size_t)l * MS * 384;
    u32x4 w[12];
#pragma unroll
    for (int i = 0; i < 12; ++i) { const int ch = tid + i * 512, rr = ch / 96, cc = ch - rr * 96; const int r = 64 * j + rr; w[i] = *(const u32x4*)(PROJ + (size_t)(r < MTOT ? r : MTOT - 1) * NPROJ + CK_ + cc * 8); }
#pragma unroll
    for (int i = 0; i < 12; ++i) { const int ch = tid + i * 512, rr = ch / 96, cc = ch - rr * 96; const int r = 64 * j + rr;
        if (r < MTOT) { const bool isP = r < MP; const int rl = isP ? r : r - MP; const int c8 = cc * 8;
            float* d = c8 < 384 ? (isP ? kp : ks) + (size_t)rl * 384 + c8 : (isP ? vp : vs) + (size_t)rl * 384 + (c8 - 384);
            *(f32x4*)d = (f32x4){bf_lo(w[i].x), bf_hi(w[i].x), bf_lo(w[i].y), bf_hi(w[i].y)}; *(f32x4*)(d + 4) = (f32x4){bf_lo(w[i].z), bf_hi(w[i].z), bf_lo(w[i].w), bf_hi(w[i].w)}; } }
}

DI void pool_item(const PV& p, int l, int grp, int b, int j, unsigned char* shm) {
    int tid_ = threadIdx.x; asm volatile("" : "+v"(tid_)); const int tid = tid_, wid = tid >> 6, lane = tid & 63, col = lane & 31, hi = lane >> 5;
    const bf16_t* PROJ = (const bf16_t*)(p.ws() + WS_PROJ); bf16_t* MIX = (bf16_t*)(p.ws() + WS_MIX); const bf16_t* PWT = (const bf16_t*)(p.ws() + WS_PWT);
    float* EXT = (float*)shm; bf16_t* D = (bf16_t*)(shm + 80896);
    const int t0 = 64 * j, tlim = grp == 0 ? TP : DS; const size_t rbase = grp == 0 ? (size_t)b * TP : (size_t)MP + b * 32;
    {
        u32x2 xr[10]; f32x4 xs_[10];
#pragma unroll
        for (int it = 0; it < 10; ++it) {
            const int idx = tid + it * 512, e = idx >> 6, ch = 4 * (idx & 63), t = t0 - 15 + e; xr[it] = (u32x2){0u, 0u}; xs_[it] = (f32x4){0.f, 0.f, 0.f, 0.f};
            if (idx < 79 * 64) {
                if (t >= 0) { if (t < tlim) xr[it] = *(const u32x2*)(PROJ + (rbase + t) * NPROJ + CU_ + ch); }
                else if (grp == 1) xs_[it] = *(const f32x4*)(p.state_pool() + ((size_t)(l * DB + b) * 15 + 15 + t) * 256 + ch);
            }
        }
#pragma unroll
        for (int it = 0; it < 10; ++it) {
            const int idx = tid + it * 512, e = idx >> 6, ch = 4 * (idx & 63);
            if (idx < 79 * 64) *(f32x4*)(EXT + e * 256 + ch) = xs_[it] + (f32x4){bf_lo(xr[it].x), bf_hi(xr[it].x), bf_lo(xr[it].y), bf_hi(xr[it].y)};
        }
    }
    __syncthreads();
    { const int ch = tid & 255, half = tid >> 8, g = ch >> 6, w = 2 << g;
      for (int s = half * 32; s < half * 32 + 32; ++s) {
          float sum = 0.f; for (int k = 0; k < w; ++k) sum += EXT[(s + 15 - k) * 256 + ch];
          const int t = t0 + s; const int cnt = grp == 0 ? (t + 1 < w ? t + 1 : w) : w;
          D[s * 264 + ch] = f2bf(sum / (float)cnt - EXT[(s + 15) * 256 + ch]);
      } }
    __syncthreads();
    { const int g = wid >> 1, sb = wid & 1; f32x16 y0, y1;
#pragma unroll
      for (int i = 0; i < 16; ++i) { y0[i] = 0.f; y1[i] = 0.f; }
      const bf16_t* wp = PWT + (size_t)(l * 4 + g) * 4096;
#pragma unroll
      for (int ks = 0; ks < 4; ++ks) {
          const int ko = 16 * ks + 8 * hi;
          const bf16x8 a0 = *(const bf16x8*)(wp + col * 64 + ko), a1 = *(const bf16x8*)(wp + (32 + col) * 64 + ko);
          const bf16x8 bq = *(const bf16x8*)(D + (32 * sb + col) * 264 + g * 64 + ko);
          y0 = MFMA32(a0, bq, y0); y1 = MFMA32(a1, bq, y1);
      }
      const int t = t0 + 32 * sb + col;
      if (t < tlim) { bf16_t* op = MIX + (rbase + t) * 1024 + 384 + g * 64; const float* sc = p.pool_scale() + (size_t)l * 256 + g * 64;
#pragma unroll
          for (int gq = 0; gq < 4; ++gq) { const int e0 = 8 * gq + 4 * hi; const f32x4 s0 = *(const f32x4*)(sc + e0), s1 = *(const f32x4*)(sc + 32 + e0);
              u32x2 w0 = {pack2(y0[4 * gq] * s0[0], y0[4 * gq + 1] * s0[1]), pack2(y0[4 * gq + 2] * s0[2], y0[4 * gq + 3] * s0[3])};
              u32x2 w1 = {pack2(y1[4 * gq] * s1[0], y1[4 * gq + 1] * s1[1]), pack2(y1[4 * gq + 2] * s1[2], y1[4 * gq + 3] * s1[3])};
              *(u32x2*)(op + e0) = w0; *(u32x2*)(op + 32 + e0) = w1; } }
    }
}
#ifndef REP_P0
#define REP_P0 1
#endif
#ifndef REP_SSDC
#define REP_SSDC 1
#endif
#ifndef REP_P2
#define REP_P2 1
#endif
#ifndef REP_GEMM
#define REP_GEMM 1
#endif
#ifndef REP_SYNC
#define REP_SYNC 1
#endif
#ifndef PHMASK
#define PHMASK 8191
#endif
DI int next_item(unsigned* ctr, int* slot) { __syncthreads(); if (threadIdx.x == 0) *slot = (int)atomicAdd(ctr, 1u); __syncthreads(); return *slot; }
constexpr int N_ATT_P = 24 * 17, N_ATT_S = DB * 6, N_SSD = NB * NCH + DB, N_POOL = NB * NCH + DB, N_KV = MTOT / 64, N_P2 = N_ATT_P + N_ATT_S + N_SSD + N_POOL + N_KV;
constexpr size_t LDS_BYTES = 131072 + 1024;

__global__ void __launch_bounds__(512, 2) hymba_fwd(Params params) {
    const PV p{};
    extern __shared__ __attribute__((aligned(16))) unsigned char shm[];
    cg::grid_group grid = cg::this_grid();
    int* slot = (int*)(shm + 131072);
    volatile LAS unsigned* xst = (volatile LAS unsigned*)(PG8_LAS unsigned char*)(shm + 131072 + 16);
    if (threadIdx.x == 0) { xst[0] = 0u; xst[1] = 0u; }
    __syncthreads();
    (void)xcd_barrier_post((unsigned*)(p.ws() + WS_BAR), xst);
    PG8_LAS unsigned char* lds = (PG8_LAS unsigned char*)shm;


    for (int ph = 0; ph < 1 + 9 * DEPTH; ++ph) {
        const int l = ph == 0 ? 0 : (ph - 1) / 9, k = ph == 0 ? -1 : (ph - 1) % 9;
        switch (k) {
        case -1:
#if PHMASK & 1
 for (int rep = 0; rep < REP_P0; ++rep) { phase0_weights(p, shm); row_phase(p, 0, nullptr, false, 0); }
#endif
 break;
        case 0: {
            pg8::Gemm g{(const bf16_t*)(p.ws() + WS_H), (const bf16_t*)(p.ws() + WS_WIN + l * SZ_WIN), MPAD, NPROJ, 1024};
            pg8::StaticOrder S; S.init(MPAD, NPROJ, (int)gridDim.x, (int)blockIdx.x, 1024);
            float* o = p.out();
            EpiIn E{(bf16_t*)(p.ws() + WS_PROJ), (bf16_t*)(p.ws() + WS_VT), (float*)(p.ws() + WS_DT), p.fox_f_bias() + l * 6, p.dt_bias() + l * 6, (const float*)(p.ws() + WS_RSTD),
                    o + OFF_KP + (size_t)l * MP * 384, o + OFF_KS + (size_t)l * MS * 384, o + OFF_VP + (size_t)l * MP * 384, o + OFF_VS + (size_t)l * MS * 384,
                    o + OFF_LP + (size_t)l * MP * 6, o + OFF_LS + (size_t)l * MS * 6, o + OFF_PP + (size_t)l * NB * 15 * 256, o + OFF_PS + (size_t)l * DB * 15 * 256,
                    o + OFF_CP + (size_t)l * NB * 3 * 640, o + OFF_CS + (size_t)l * DB * 3 * 640};
#if PHMASK & 2
            for (int rep = 0; rep < REP_GEMM; ++rep) pg8::gemm_phase<EpiIn, pg8::StaticOrder, false>(lds, g, S, E, nullptr);
#endif
        } break;
        case 1:
          for (int rep = 0; rep < REP_P2; ++rep) {
            unsigned* qctr = (unsigned*)(p.ws() + WS_CTR) + l + 8 * rep;
            int nxt = 0; if (threadIdx.x == 0) nxt = (int)atomicAdd(qctr, 1u);
            for (;;) {
                __syncthreads(); if (threadIdx.x == 0) *slot = nxt; __syncthreads();
                const int it = *slot;
                if (it >= N_P2) break;
                if (threadIdx.x == 0) nxt = (int)atomicAdd(qctr, 1u);
                if (it < N_ATT_P) { const int qi = 16 - it / 24, bh = it % 24;
#if PHMASK & 4
if (attn_prompt_fast(p, l, bh / 6, bh % 6, qi, shm)) attn_prompt(p, l, bh / 6, bh % 6, qi, shm);
#endif
 }
                else if (it < N_ATT_P + N_ATT_S) { const int a = it - N_ATT_P;
#if PHMASK & 8
attn_sample(p, l, a / 6, a % 6, shm);
#endif
 }
                else if (it < N_ATT_P + N_ATT_S + N_SSD) { const int j = it - N_ATT_P - N_ATT_S; const int grp = j < NB * NCH ? 0 : 1; const int b = grp == 0 ? j / NCH : j - NB * NCH, c = grp == 0 ? j % NCH : 0;
#if PHMASK & 16
ssd_a(p, l, grp, b, c, shm);
#endif
 }
                else if (it >= N_ATT_P + N_ATT_S + N_SSD + N_POOL) kv_out_item(p, l, it - N_ATT_P - N_ATT_S - N_SSD - N_POOL);
                else { const int j = it - N_ATT_P - N_ATT_S - N_SSD; const int grp = j < NB * NCH ? 0 : 1; const int b = grp == 0 ? j / NCH : j - NB * NCH, c = grp == 0 ? j % NCH : 0;
#if PHMASK & 32
pool_item(p, l, grp, b, c, shm);
#endif
 }
            }
          }
            break;
        case 2:
#if PHMASK & 64
 ssd_scan(p, l);
#endif
 break;
        case 3:
          for (int rep = 0; rep < REP_SSDC; ++rep)
            for (int j = blockIdx.x; j < N_SSD; j += gridDim.x) {
                const int grp = j < NB * NCH ? 0 : 1; const int b = grp == 0 ? j / NCH : j - NB * NCH, c = grp == 0 ? j % NCH : 0;
#if PHMASK & 128
                ssd_c(p, l, grp, b, c, shm); __syncthreads();
#endif
            }
            break;
        case 4: {
            pg8::Gemm g{(const bf16_t*)(p.ws() + WS_MIX), (const bf16_t*)(p.ws() + WS_WOUT + l * SZ_WOUT), MPAD, 1024, 1024};
            SplitOrder S{4, 16, (int)gridDim.x, (int)blockIdx.x};
            EpiOutB E{(bf16_t*)(p.ws() + WS_OUT), (float*)(p.ws() + WS_PART)};
#if PHMASK & 256
            for (int rep = 0; rep < REP_GEMM; ++rep) pg8::gemm_phase<EpiOutB, SplitOrder, false>(lds, g, S, E, nullptr);
#endif
        } break;
        case 5:
#if PHMASK & 512

#ifdef REP_ROW
 row_phase(p, 1, p.ln_post_mix() + (size_t)l * 1024, false, 4, true);
#endif
 row_phase(p, 1, p.ln_post_mix() + (size_t)l * 1024, false, 4);
#endif
 break;
        case 6: {
            pg8::Gemm g{(const bf16_t*)(p.ws() + WS_H), (const bf16_t*)(p.ws() + WS_WGU + l * SZ_WGU), MPAD, 2 * DFF, 1024};
            pg8::StaticOrder S; S.init(MPAD, 2 * DFF, (int)gridDim.x, (int)blockIdx.x, 1024);
            EpiGU E{(bf16_t*)(p.ws() + WS_HID), (const float*)(p.ws() + WS_RSTD)};
#if PHMASK & 1024
            for (int rep = 0; rep < REP_GEMM; ++rep) pg8::gemm_phase<EpiGU, pg8::StaticOrder, false>(lds, g, S, E, nullptr);
#endif
        } break;
        case 7: {
            pg8::Gemm g{(const bf16_t*)(p.ws() + WS_HID), (const bf16_t*)(p.ws() + WS_WDN + l * SZ_WDN), MPAD, 1024, DFF};
            SplitOrder S{11, 44, (int)gridDim.x, (int)blockIdx.x};
            EpiOutB E{(bf16_t*)(p.ws() + WS_OUT), (float*)(p.ws() + WS_PART)};
#if PHMASK & 2048
            for (int rep = 0; rep < REP_GEMM; ++rep) pg8::gemm_phase<EpiOutB, SplitOrder, false>(lds, g, S, E, nullptr);
#endif
        } break;
        default:
#if PHMASK & 4096

#ifdef REP_ROW
 row_phase(p, 1, p.ln_post_ffn() + (size_t)l * 1024, false, 11, true);
#endif
 row_phase(p, 1, p.ln_post_ffn() + (size_t)l * 1024, l + 1 == DEPTH, 11);
#endif
 break;
        }
        if (ph + 1 < 1 + 9 * DEPTH) { for (int rep = 0; rep < REP_SYNC; ++rep) {
            if (ph == 0) grid.sync();
            else { XcdBarrier xb; xb.bar = (unsigned*)(p.ws() + WS_BAR); xb.x = xb_xcc_id(); xb.st = xst; xcd_barrier(xb); } } }
    }
}

extern "C" void kernel_launch(void* const* d_in, const int* in_sizes, int n_in, void* d_out, int out_size, void* d_ws, size_t ws_size, hipStream_t stream) {
    static int grid_blocks = 0;
    if (!grid_blocks) {
        if (hipFuncSetAttribute((const void*)hymba_fwd, hipFuncAttributeMaxDynamicSharedMemorySize, (int)LDS_BYTES) != hipSuccess) { fprintf(stderr, "hipFuncSetAttribute failed\n"); return; }
        int dev = 0, cus = 0, per_cu = 0;
        (void)hipGetDevice(&dev);
        (void)hipDeviceGetAttribute(&cus, hipDeviceAttributeMultiprocessorCount, dev);
        if (hipOccupancyMaxActiveBlocksPerMultiprocessor(&per_cu, (const void*)hymba_fwd, 512, LDS_BYTES) != hipSuccess || per_cu < 1) { fprintf(stderr, "occupancy query failed\n"); return; }
        grid_blocks = cus * 1;
    }
    if (ws_size < WS_END) { fprintf(stderr, "workspace too small\n"); return; }
    Params p{};
    const float* const* in = (const float* const*)d_in;
    p.x_prompt = in[0]; p.x_sample = in[1]; p.cache_k = in[2]; p.cache_v = in[3]; p.cache_logf = in[4]; p.state_pool = in[5]; p.state_conv = in[6]; p.state_ssd = in[7];
    p.meta = in[8]; p.ln_pre_mix = in[9]; p.ln_post_mix = in[10]; p.ln_pre_ffn = in[11]; p.ln_post_ffn = in[12]; p.w_in = in[13]; p.fox_f_bias = in[14]; p.pool_w = in[15];
    p.pool_scale = in[16]; p.conv_w = in[17]; p.conv_b = in[18]; p.dt_bias = in[19]; p.a_log = in[20]; p.d_skip = in[21]; p.ssd_norm = in[22]; p.w_out = in[23];
    p.w_gate = in[24]; p.w_up = in[25]; p.w_down = in[26];
    p.out = (float*)d_out; p.ws = (unsigned char*)d_ws;
    (void)hipMemsetAsync((unsigned char*)d_ws + WS_CTR, 0, 4096 + 16384, stream);
    void* args[] = {&p};
    hipError_t e = hipLaunchCooperativeKernel((const void*)hymba_fwd, dim3(grid_blocks), dim3(512), args, LDS_BYTES, stream);
    if (e != hipSuccess) fprintf(stderr, "cooperative launch failed: %s (grid %d)\n", hipGetErrorString(e), grid_blocks);
}
```

```cpp
#include <hip/hip_runtime.h>
#include <hip/hip_cooperative_groups.h>
#include <cstdio>
#include <cstdint>
namespace pg8 {
#define PG8_LAS __attribute__((address_space(3)))
typedef unsigned short bf16_t;
typedef short bf16x8 __attribute__((ext_vector_type(8)));
typedef float f32x4 __attribute__((ext_vector_type(4)));
typedef unsigned u32x4 __attribute__((ext_vector_type(4)));
constexpr int BM = 256, BK = 64, HALF = 128, HTB = HALF * BK * 2  , STAGE_BYTES = 8 * HTB, NXCD = 8, WGM = 8;

__host__ __device__ __forceinline__ int lds_byte(int r, int c) { const int st = (r >> 4) * 2 + (c >> 5), rr = r & 15, cc = c & 31, ob = rr * 64 + cc * 2; return st * 1024 + (ob ^ (((ob >> 9) & 1) << 5)); }
__host__ __device__ __forceinline__ void stage_rc(int b, int& R, int& C) { const int st = b / 1024, sb = b % 1024, swz = sb ^ (((sb >> 9) & 1) << 5); R = (st >> 1) * 16 + swz / 64; C = (st & 1) * 32 + (swz % 64) / 2; }
__host__ __device__ __forceinline__ int perm32(int rho) { const int n = rho >> 4, i = rho & 15; return 8 * (i >> 2) + 4 * n + (i & 3); }

struct Unit { int pm, pn, nt, koff, slice; };
struct Gemm { const bf16_t* A; const bf16_t* Bt; int M, N, K; };

struct StaticOrder {
    int nM, nN, nwg, G, c, ntk;
    __host__ __device__ void init(int M, int N, int G_, int c_, int K_) { nM = M / BM; nN = N / BM; nwg = nM * nN; G = G_; c = c_; ntk = K_ / BK; }
    __host__ __device__ bool next(int i, Unit& u) const {
        const long L = (long)i * G + c; if (L >= nwg) return false;
        int wgid = (int)L; { const int q = nwg / NXCD, r = nwg % NXCD, xcd = wgid % NXCD, off = wgid / NXCD; wgid = (xcd < r ? xcd * (q + 1) : r * (q + 1) + (xcd - r) * q) + off; }
        const int nig = WGM * nN, gid = wgid / nig, fm = gid * WGM, gsz = (nM - fm) < WGM ? (nM - fm) : WGM;
        u.pm = fm + ((wgid % nig) % gsz); u.pn = (wgid % nig) / gsz; u.nt = ntk; u.koff = 0; u.slice = -1; return true;
    }
    __device__ __forceinline__ void a_ready(const Unit&) const {}
    __device__ __forceinline__ void done(const Unit&) const {}
};

template <class Epi, class Sched, bool STAMP = false>
__device__ __forceinline__ void gemm_phase(PG8_LAS unsigned char* lds, const Gemm g, const Sched& S, const Epi& E, unsigned long long* stamps) {
    int tid_ = threadIdx.x; asm volatile("" : "+v"(tid_));
    const int tid = tid_, wid = __builtin_amdgcn_readfirstlane(tid >> 6), lane = tid & 63, wr = wid >> 2, wc = wid & 3, fr = lane & 15, fq = lane >> 4;
    const int K = g.K;
    int ts_lo = 0, ts_hi = 0, nts = 0; const unsigned long long rt_entry = STAMP ? (unsigned long long)wall_clock64() : 0ull;
#define PG8_STAMP() do { if (STAMP && wid == 0 && nts < 64) { const unsigned long long _c = (unsigned long long)clock64(); \
        ts_lo = (lane == nts) ? (int)(unsigned)_c : ts_lo; ts_hi = (lane == nts) ? (int)(unsigned)(_c >> 32) : ts_hi; ++nts; } } while (0)
    PG8_STAMP();
    unsigned voffA[2], voffB[2];
#pragma unroll
    for (int i = 0; i < 2; ++i) { int R, C; stage_rc(tid * 16 + i * 8192, R, C); const int Rb = Epi::PERM ? ((R & ~31) + perm32(R & 31)) : R;
        voffA[i] = (unsigned)(R * K + C) * 2u; voffB[i] = (unsigned)(Rb * K + C) * 2u; }
    const size_t kstep = (size_t)(BK * 2);
    const size_t hstep = (size_t)HALF * K * 2;
    const size_t tstep = 2 * hstep;
    const unsigned ldsw = (unsigned)wid * 1024u;
    const int aoff = lds_byte(wr * 64 + fr, fq * 8), boff = lds_byte(wc * 32 + fr, fq * 8);
#define PG8_SA(b, h) (((b) * 2 + (h)) * HTB)
#define PG8_SB(b, h) ((4 + (b) * 2 + (h)) * HTB)
#define PG8_STAGE(bufoff, gbase, voff) do { _Pragma("unroll") for (int _i = 0; _i < 2; ++_i) \
        __builtin_amdgcn_global_load_lds((const unsigned*)((const char*)(gbase) + (voff)[_i]), (PG8_LAS unsigned*)(lds + (bufoff) + ldsw + _i * 8192), 16, 0, 0); } while (0)
#define PG8_LDA(dst, b, h) do { _Pragma("unroll") for (int m = 0; m < 4; ++m) _Pragma("unroll") for (int k = 0; k < 2; ++k) dst[m][k] = *(const PG8_LAS bf16x8*)(lds + PG8_SA(b, h) + aoff + m * 2048 + k * 1024); } while (0)
#define PG8_LDB(dst, b, h) do { _Pragma("unroll") for (int n = 0; n < 2; ++n) _Pragma("unroll") for (int k = 0; k < 2; ++k) dst[n][k] = *(const PG8_LAS bf16x8*)(lds + PG8_SB(b, h) + boff + n * 2048 + k * 1024); } while (0)
#define PG8_MMA(ai, bj, At, Bt) do { __builtin_amdgcn_s_setprio(1); _Pragma("unroll") for (int m = 0; m < 4; ++m) _Pragma("unroll") for (int n = 0; n < 2; ++n) _Pragma("unroll") for (int k = 0; k < 2; ++k) \
        acc[ai][bj][m][n] = __builtin_amdgcn_mfma_f32_16x16x32_bf16(Bt[n][k], At[m][k], acc[ai][bj][m][n], 0, 0, 0); __builtin_amdgcn_s_setprio(0); } while (0)
#define PG8_WAIT_V(n) asm volatile("s_waitcnt vmcnt(" #n ")" ::: "memory")
#define PG8_WAIT_L(n) asm volatile("s_waitcnt lgkmcnt(" #n ")" ::: "memory")
#define PG8_BAR __builtin_amdgcn_s_barrier()
#define PG8_SCHED __builtin_amdgcn_sched_barrier(0)
    Unit cur, nxt; int ui = 0;
    if (!S.next(0, cur)) return;
    f32x4 acc[2][2][4][2];
#pragma unroll
    for (int a = 0; a < 2; ++a)
#pragma unroll
        for (int b = 0; b < 2; ++b)
#pragma unroll
            for (int m = 0; m < 4; ++m)
#pragma unroll
                for (int n = 0; n < 2; ++n) acc[a][b][m][n] = (f32x4){0.f, 0.f, 0.f, 0.f};
    bf16x8 At[4][2], B0[2][2], B1[2][2];
    const char* cA = (const char*)g.A + (size_t)cur.pm * tstep + (size_t)cur.koff * 2; const char* cB = (const char*)g.Bt + (size_t)cur.pn * tstep + (size_t)cur.koff * 2;
    S.a_ready(cur);
    PG8_STAGE(PG8_SB(0, 0), cB, voffB); PG8_STAGE(PG8_SA(0, 0), cA, voffA); PG8_STAGE(PG8_SB(0, 1), cB + hstep, voffB); PG8_STAGE(PG8_SA(0, 1), cA + hstep, voffA);
    if (wr == 1) PG8_BAR;
    PG8_WAIT_V(4); PG8_BAR;
    PG8_STAGE(PG8_SB(1, 0), cB + kstep, voffB); PG8_STAGE(PG8_SA(1, 0), cA + kstep, voffA); PG8_STAGE(PG8_SB(1, 1), cB + hstep + kstep, voffB);
    PG8_WAIT_V(6); PG8_BAR;
    PG8_STAMP();
    for (;;) {
        const bool has_next = S.next(ui + 1, nxt);
        const char* nA = has_next ? (const char*)g.A + (size_t)nxt.pm * tstep + (size_t)nxt.koff * 2 : cA; const char* nB = has_next ? (const char*)g.Bt + (size_t)nxt.pn * tstep + (size_t)nxt.koff * 2 : cB;
        const int nt = cur.nt;
        for (int t = 0; t < nt; t += 2) {
            const bool last = (t == nt - 2);
            const char* a1 = cA + (size_t)(t + 1) * kstep;
            const char* a2 = last ? nA : cA + (size_t)(t + 2) * kstep; const char* b2 = last ? nB : cB + (size_t)(t + 2) * kstep;
            const char* a3 = a2 + kstep; const char* b3 = b2 + kstep;
            if (last && has_next) S.a_ready(nxt);
            PG8_LDB(B0, 0, 0); PG8_SCHED; PG8_LDA(At, 0, 0); PG8_STAGE(PG8_SA(1, 1), a1 + hstep, voffA);
            PG8_WAIT_L(8); PG8_BAR; PG8_WAIT_L(0); PG8_MMA(0, 0, At, B0); PG8_BAR; PG8_SCHED;
            PG8_LDB(B1, 0, 1); PG8_STAGE(PG8_SB(0, 0), b2, voffB);
            PG8_BAR; PG8_WAIT_L(0); PG8_MMA(0, 1, At, B1); PG8_BAR;
            PG8_LDA(At, 0, 1); PG8_STAGE(PG8_SA(0, 0), a2, voffA);
            PG8_BAR; PG8_WAIT_L(0); PG8_MMA(1, 0, At, B0); PG8_BAR; PG8_SCHED;
            PG8_STAGE(PG8_SB(0, 1), b2 + hstep, voffB);
            PG8_WAIT_V(6); PG8_BAR; PG8_MMA(1, 1, At, B1); PG8_BAR;
            PG8_LDB(B0, 1, 0); PG8_SCHED; PG8_LDA(At, 1, 0); PG8_STAGE(PG8_SA(0, 1), a2 + hstep, voffA);
            PG8_WAIT_L(8); PG8_BAR; PG8_WAIT_L(0); PG8_MMA(0, 0, At, B0); PG8_BAR; PG8_SCHED;
            PG8_LDB(B1, 1, 1); PG8_STAGE(PG8_SB(1, 0), b3, voffB);
            PG8_BAR; PG8_WAIT_L(0); PG8_MMA(0, 1, At, B1); PG8_BAR;
            PG8_LDA(At, 1, 1); PG8_STAGE(PG8_SA(1, 0), a3, voffA);
            PG8_BAR; PG8_WAIT_L(0); PG8_MMA(1, 0, At, B0); PG8_BAR; PG8_SCHED;
            PG8_STAGE(PG8_SB(1, 1), b3 + hstep, voffB);
            PG8_WAIT_V(6); PG8_BAR; PG8_MMA(1, 1, At, B1); PG8_BAR;
        }
        PG8_STAMP();
        if constexpr (!Epi::AFTER_DRAIN) {
            if (wr == 0) PG8_BAR;
            E(acc, cur, wr, wc, fr, fq); S.done(cur);
            if (wr == 1) PG8_BAR;
        }
        PG8_STAMP();
        if (!has_next) break;
#pragma unroll
        for (int a = 0; a < 2; ++a)
#pragma unroll
            for (int b = 0; b < 2; ++b)
#pragma unroll
                for (int m = 0; m < 4; ++m)
#pragma unroll
                    for (int n = 0; n < 2; ++n) acc[a][b][m][n] = (f32x4){0.f, 0.f, 0.f, 0.f};
        cur = nxt; cA = nA; cB = nB; ++ui;
    }
    PG8_WAIT_V(0);
    if (wr == 0) PG8_BAR;
    PG8_BAR;
    if constexpr (Epi::AFTER_DRAIN) { E.fused(acc, cur, wr, wc, fr, fq, lds, wid, lane); S.done(cur); }
    PG8_STAMP();
    if (STAMP && wid == 0) { stamps[lane] = lane < nts ? (((unsigned long long)(unsigned)ts_hi << 32) | (unsigned)ts_lo) : 0ull;
        if (lane == 62) stamps[62] = rt_entry; if (lane == 63) stamps[63] = (unsigned long long)wall_clock64(); }
#undef PG8_STAMP
#undef PG8_SA
#undef PG8_SB
#undef PG8_STAGE
#undef PG8_LDA
#undef PG8_LDB
#undef PG8_MMA
#undef PG8_WAIT_V
#undef PG8_WAIT_L
#undef PG8_BAR
#undef PG8_SCHED
}
}
#define XB_TMO      128
#define XB_XCNT(j)  (256  + 64 * (j))
#define XB_XSUB(j)  (1280 + 64 * (j))
#define XB_XGEN(j)  (2304 + 64 * (j))
#define XB_TOP      3328
#define XB_TOPGEN   3392
#define XCD_BAR_WORDS 3456
#define XB_SPIN_CAP (1u << 18)
#define LAS __attribute__((address_space(3)))

__device__ __forceinline__ unsigned xb_ld(unsigned* p)              { return __hip_atomic_load(p, __ATOMIC_RELAXED, __HIP_MEMORY_SCOPE_AGENT); }
__device__ __forceinline__ unsigned xb_add(unsigned* p, unsigned v) { return __hip_atomic_fetch_add(p, v, __ATOMIC_RELAXED, __HIP_MEMORY_SCOPE_AGENT); }
__device__ __forceinline__ unsigned xb_xcc_id() { return (unsigned)__builtin_amdgcn_s_getreg((3 << 11) | 20) & 0xFu; }
#define XB_SPIN(cond, bar) do { unsigned _sp = 0; while (cond) { __builtin_amdgcn_s_sleep(1); \
    if ((++_sp & 255u) == 0u) { if (xb_ld(&(bar)[XB_TMO])) break; if (_sp > XB_SPIN_CAP) { atomicAdd(&(bar)[XB_TMO], 1u); break; } } } } while (0)

struct XcdBarrier {
    unsigned* bar; unsigned x;
    volatile LAS unsigned* st;
};

__device__ __forceinline__ XcdBarrier xcd_barrier_post(unsigned* bar, volatile LAS unsigned* st) {
    XcdBarrier b; b.bar = bar; b.x = xb_xcc_id(); b.st = st;
    if (threadIdx.x == 0) (void)xb_add(&bar[XB_XCNT(b.x)], 1u);
    return b;
}
__device__ __forceinline__ void xcd_barrier_complete(unsigned* bar, unsigned x, unsigned& nloc, unsigned& nx) {
    const unsigned G = gridDim.x * gridDim.y * gridDim.z;
    unsigned sum, cnt, mine, sp = 0u;
    for (;;) {
        sum = 0u; cnt = 0u; mine = 0u;
#pragma unroll
        for (unsigned j = 0; j < 16; ++j) { const unsigned c = xb_ld(&bar[XB_XCNT(j)]); sum += c; cnt += (c > 0u) ? 1u : 0u; mine = (j == x) ? c : mine; }
        if (sum == G) break;
        __builtin_amdgcn_s_sleep(1);
        if ((++sp & 255u) == 0u) { if (xb_ld(&bar[XB_TMO])) break; if (sp > XB_SPIN_CAP) { atomicAdd(&bar[XB_TMO], 1u); break; } }
    }
    nloc = mine > 0u ? mine : 1u; nx = cnt > 0u ? cnt : 1u;
}

__device__ __forceinline__ void xcd_barrier(const XcdBarrier& b) {
    asm volatile("s_waitcnt vmcnt(0)" ::: "memory");
    __syncthreads();
    if (threadIdx.x == 0) {
        unsigned* bar = b.bar;
        __builtin_amdgcn_s_waitcnt(0);
        unsigned nloc = b.st[0], nx = b.st[1];
        if (nloc == 0u) { xcd_barrier_complete(bar, b.x, nloc, nx); b.st[0] = nloc; b.st[1] = nx; }
        const unsigned old = xb_add(&bar[XB_XSUB(b.x)], 1u);
        const unsigned gen = old / nloc;
        if (old + 1u == (gen + 1u) * nloc) {
            __builtin_amdgcn_fence(__ATOMIC_RELEASE, "agent");
            asm volatile("s_waitcnt vmcnt(0)" ::: "memory");
            const unsigned og = xb_add(&bar[XB_TOP], 1u);
            const unsigned tg = og / nx;
            if (og + 1u == (tg + 1u) * nx) xb_add(&bar[XB_TOPGEN], 1u);
            else XB_SPIN(xb_ld(&bar[XB_TOPGEN]) == tg, bar);
            __builtin_amdgcn_fence(__ATOMIC_ACQUIRE, "agent");
            xb_add(&bar[XB_XGEN(b.x)], 1u);
            asm volatile("s_waitcnt vmcnt(0)" ::: "memory");
        } else {
            XB_SPIN(xb_ld(&bar[XB_XGEN(b.x)]) == gen, bar);
            __builtin_amdgcn_fence(__ATOMIC_ACQUIRE, "agent");
            asm volatile("s_waitcnt vmcnt(0)" ::: "memory");
        }
    }
    __syncthreads();
}

namespace cg = cooperative_groups;
using pg8::bf16_t; using pg8::bf16x8; using pg8::f32x4; using pg8::u32x4;
typedef float f32x16 __attribute__((ext_vector_type(16)));
typedef unsigned u32x2 __attribute__((ext_vector_type(2)));
#define MFMA32(a, b, c) __builtin_amdgcn_mfma_f32_32x32x16_bf16((a), (b), (c), 0, 0, 0)
#define DI __device__ __forceinline__

constexpr int DMODEL = 1024, NB = 4, SEQ = 4096, NMETA = 16, TP = SEQ + NMETA, DEPTH = 4, DB = 32, DS = 32, PAST = 1024;
constexpr int MP = NB * TP, MS = DB * DS, MTOT = MP + MS, MPAD = 17664;
constexpr int NPROJ = 2560, DFF = 2816, NCH = 65, MMAIN = 16384, MTAILP = 1280;
constexpr int CK_ = 384, CV_ = 768, CU_ = 1152, CZ_ = 1408, CX_ = 1792, CF_ = 2432, CDT_ = 2440;
constexpr float EPS = 1e-6f, LOG2E = 1.4426950408889634f, QSCALE = 0.125f * 1.4426950408889634f;
constexpr size_t OFF_Y = 0, OFF_YS = OFF_Y + (size_t)NB * SEQ * 1024, OFF_KP = OFF_YS + (size_t)DB * DS * 1024,
                 OFF_VP = OFF_KP + (size_t)DEPTH * MP * 384, OFF_LP = OFF_VP + (size_t)DEPTH * MP * 384, OFF_PP = OFF_LP + (size_t)DEPTH * MP * 6,
                 OFF_CP = OFF_PP + (size_t)DEPTH * NB * 15 * 256, OFF_SP = OFF_CP + (size_t)DEPTH * NB * 3 * 640, OFF_KS = OFF_SP + (size_t)DEPTH * NB * 6 * 4096,
                 OFF_VS = OFF_KS + (size_t)DEPTH * MS * 384, OFF_LS = OFF_VS + (size_t)DEPTH * MS * 384, OFF_PS = OFF_LS + (size_t)DEPTH * MS * 6,
                 OFF_CS = OFF_PS + (size_t)DEPTH * DB * 15 * 256, OFF_SS = OFF_CS + (size_t)DEPTH * DB * 3 * 640;
constexpr size_t al256(size_t x) { return (x + 255) & ~(size_t)255; }
constexpr size_t WS_CTR = 0, WS_BAR = 4096, WS_WIN = 4096 + 16384, SZ_WIN = (size_t)NPROJ * 1024 * 2, WS_WOUT = WS_WIN + DEPTH * SZ_WIN, SZ_WOUT = (size_t)1024 * 1024 * 2,
                 WS_WGU = WS_WOUT + DEPTH * SZ_WOUT, SZ_WGU = (size_t)2 * DFF * 1024 * 2, WS_WDN = WS_WGU + DEPTH * SZ_WGU, SZ_WDN = (size_t)1024 * DFF * 2,
                 WS_PWT = WS_WDN + DEPTH * SZ_WDN, WS_X = WS_PWT + (size_t)DEPTH * 4 * 4096 * 2, WS_H = WS_X + (size_t)MPAD * 1024 * 4,
                 WS_PROJ = WS_H + (size_t)MPAD * 1024 * 2, WS_VT = WS_PROJ + (size_t)MPAD * NPROJ * 2, WS_DT = WS_VT + al256((size_t)NB * 6 * 64 * 4160 * 2),
                 WS_MIX = WS_DT + (size_t)MPAD * 8 * 4, WS_OUT = WS_MIX + (size_t)MPAD * 1024 * 2, WS_HID = WS_OUT + (size_t)MPAD * 1024 * 4,
                 WS_Y32 = WS_HID + (size_t)MPAD * DFF * 2, WS_CC = WS_Y32 + (size_t)MPAD * 384 * 4, WS_ACS = WS_CC + (size_t)MPAD * 128 * 2,
                 WS_ST = WS_ACS + (size_t)MPAD * 8 * 4, WS_PART = WS_ST + (size_t)NB * NCH * 6 * 4096 * 4, WS_RSTD = WS_PART + (size_t)11 * 1280 * 1024 * 4, WS_END = WS_RSTD + (size_t)MPAD * 4;

struct Params {
    const float *x_prompt, *x_sample, *cache_k, *cache_v, *cache_logf, *state_pool, *state_conv, *state_ssd, *meta, *ln_pre_mix, *ln_post_mix, *ln_pre_ffn, *ln_post_ffn,
        *w_in, *fox_f_bias, *pool_w, *pool_scale, *conv_w, *conv_b, *dt_bias, *a_log, *d_skip, *ssd_norm, *w_out, *w_gate, *w_up, *w_down;
    float* out; unsigned char* ws;
};

typedef __attribute__((address_space(4))) const volatile unsigned long long kav_t;
__device__ __forceinline__ unsigned long long karg_raw(int idx) { kav_t* ka = (kav_t*)__builtin_amdgcn_kernarg_segment_ptr(); return ka[idx]; }
struct PV {
    __device__ __forceinline__ const float* x_prompt() const { return (const float*)(__attribute__((address_space(1))) const float*)karg_raw(0); }
    __device__ __forceinline__ const float* x_sample() const { return (const float*)(__attribute__((address_space(1))) const float*)karg_raw(1); }
    __device__ __forceinline__ const float* cache_k() const { return (const float*)(__attribute__((address_space(1))) const float*)karg_raw(2); }
    __device__ __forceinline__ const float* cache_v() const { return (const float*)(__attribute__((address_space(1))) const float*)karg_raw(3); }
    __device__ __forceinline__ const float* cache_logf() const { return (const float*)(__attribute__((address_space(1))) const float*)karg_raw(4); }
    __device__ __forceinline__ const float* state_pool() const { return (const float*)(__attribute__((address_space(1))) const float*)karg_raw(5); }
    __device__ __forceinline__ const float* state_conv() const { return (const float*)(__attribute__((address_space(1))) const float*)karg_raw(6); }
    __device__ __forceinline__ const float* state_ssd() const { return (const float*)(__attribute__((address_space(1))) const float*)karg_raw(7); }
    __device__ __forceinline__ const float* meta() const { return (const float*)(__attribute__((address_space(1))) const float*)karg_raw(8); }
    __device__ __forceinline__ const float* ln_pre_mix() const { return (const float*)(__attribute__((address_space(1))) const float*)karg_raw(9); }
    __device__ __forceinline__ const float* ln_post_mix() const { return (const float*)(__attribute__((address_space(1))) const float*)karg_raw(10); }
    __device__ __forceinline__ const float* ln_pre_ffn() const { return (const float*)(__attribute__((address_space(1))) const float*)karg_raw(11); }
    __device__ __forceinline__ const float* ln_post_ffn() const { return (const float*)(__attribute__((address_space(1))) const float*)karg_raw(12); }
    __device__ __forceinline__ const float* w_in() const { return (const float*)(__attribute__((address_space(1))) const float*)karg_raw(13); }
    __device__ __forceinline__ const float* fox_f_bias() const { return (const float*)(__attribute__((address_space(1))) const float*)karg_raw(14); }
    __device__ __forceinline__ const float* pool_w() const { return (const float*)(__attribute__((address_space(1))) const float*)karg_raw(15); }
    __device__ __forceinline__ const float* pool_scale() const { return (const float*)(__attribute__((address_space(1))) const float*)karg_raw(16); }
    __device__ __forceinline__ const float* conv_w() const { return (const float*)(__attribute__((address_space(1))) const float*)karg_raw(17); }
    __device__ __forceinline__ const float* conv_b() const { return (const float*)(__attribute__((address_space(1))) const float*)karg_raw(18); }
    __device__ __forceinline__ const float* dt_bias() const { return (const float*)(__attribute__((address_space(1))) const float*)karg_raw(19); }
    __device__ __forceinline__ const float* a_log() const { return (const float*)(__attribute__((address_space(1))) const float*)karg_raw(20); }
    __device__ __forceinline__ const float* d_skip() const { return (const float*)(__attribute__((address_space(1))) const float*)karg_raw(21); }
    __device__ __forceinline__ const float* ssd_norm() const { return (const float*)(__attribute__((address_space(1))) const float*)karg_raw(22); }
    __device__ __forceinline__ const float* w_out() const { return (const float*)(__attribute__((address_space(1))) const float*)karg_raw(23); }
    __device__ __forceinline__ const float* w_gate() const { return (const float*)(__attribute__((address_space(1))) const float*)karg_raw(24); }
    __device__ __forceinline__ const float* w_up() const { return (const float*)(__attribute__((address_space(1))) const float*)karg_raw(25); }
    __device__ __forceinline__ const float* w_down() const { return (const float*)(__attribute__((address_space(1))) const float*)karg_raw(26); }
    __device__ __forceinline__ float* out() const { return (float*)(__attribute__((address_space(1))) float*)karg_raw(27); }
    __device__ __forceinline__ unsigned char* ws() const { return (unsigned char*)(__attribute__((address_space(1))) unsigned char*)karg_raw(28); }
};

#define AS_G(ptr) ((float*)(__attribute__((address_space(1))) float*)(ptr))
DI unsigned pack2(float lo, float hi) {
    typedef __bf16 bf2_t __attribute__((ext_vector_type(2))); typedef float fl2_t __attribute__((ext_vector_type(2)));
    fl2_t f = {lo, hi}; bf2_t b = __builtin_convertvector(f, bf2_t); return __builtin_bit_cast(unsigned, b);
}
DI float bf_lo(unsigned u) { return __uint_as_float(u << 16); }
DI float bf_hi(unsigned u) { return __uint_as_float(u & 0xffff0000u); }
DI bf16_t f2bf(float f) { return (bf16_t)(pack2(f, 0.f) & 0xffffu); }
DI float bf2f(bf16_t b) { return __uint_as_float(((unsigned)b) << 16); }
DI bf16x8 pack8(float a0, float a1, float a2, float a3, float a4, float a5, float a6, float a7) {
    u32x4 w = {pack2(a0, a1), pack2(a2, a3), pack2(a4, a5), pack2(a6, a7)}; return __builtin_bit_cast(bf16x8, w);
}
DI bf16x8 cat8(u32x2 lo, u32x2 hi) { u32x4 w = {lo.x, lo.y, hi.x, hi.y}; return __builtin_bit_cast(bf16x8, w); }
DI int crow(int i, int hi) { return (i & 3) + 8 * (i >> 2) + 4 * hi; }
DI float dpp_f(float src, int ctrl_unused) { return src; }
#define DPP_F(SRC, CTRL, RM, BC) __int_as_float(__builtin_amdgcn_update_dpp(0, __float_as_int(SRC), (CTRL), (RM), 0xf, (BC)))
DI float wave_scan_incl(float v, int lane) {
    (void)lane;
    v += DPP_F(v, 0x111, 0xf, true);
    v += DPP_F(v, 0x112, 0xf, true);
    v += DPP_F(v, 0x114, 0xf, true);
    v += DPP_F(v, 0x118, 0xf, true);
    v += DPP_F(v, 0x142, 0xa, false);
    v += DPP_F(v, 0x143, 0xc, false);
    return v;
}
DI float wave_sum(float v) { return __int_as_float(__builtin_amdgcn_readlane(__float_as_int(wave_scan_incl(v, 0)), 63)); }
DI float siluf(float x) { return x * __builtin_amdgcn_rcpf(1.f + __expf(-x)); }
DI float ex2(float x) { return __builtin_amdgcn_exp2f(x); }

DI int map_in_col(int n) {
    if (n < 1152) return n;
    if (n < 1408) return 1158 + (n - 1152);
    if (n < 1792) return 1414 + (n - 1408);
    if (n < 2432) return 1798 + (n - 1792);
    if (n < 2438) return 1152 + (n - 2432);
    if (n >= 2440 && n < 2446) return 2438 + (n - 2440);
    return -1;
}
template <int KT> DI void conv_tile(const float* W, int N, int K, int k0, int n0, int srcbase, bf16_t* out, float* tile, const float* gain = nullptr) {
    int tid_ = threadIdx.x; asm volatile("" : "+v"(tid_)); const int tid = tid_;
    const int nn = tid & 63, kb = tid >> 6; const int src = srcbase >= 0 ? srcbase + nn : map_in_col(n0 + nn);
    const float* wp = W + (size_t)(k0 + kb) * N + (src >= 0 ? src : 0);
#pragma unroll
    for (int i = 0; i < KT / 8; ++i) { float v = src >= 0 ? wp[(size_t)i * 8 * N] : 0.f; if (gain) v *= gain[k0 + kb + 8 * i]; tile[nn * (KT + 1) + kb + 8 * i] = v; }
    __syncthreads();
    { const int rn = tid >> 3, kq = tid & 7;
#pragma unroll
      for (int kc = 0; kc < KT / 64; ++kc) { const float* t = tile + rn * (KT + 1) + kc * 64 + kq * 8;
          u32x4 w = {pack2(t[0], t[1]), pack2(t[2], t[3]), pack2(t[4], t[5]), pack2(t[6], t[7])};
          *(u32x4*)(out + (size_t)(n0 + rn) * K + k0 + kc * 64 + kq * 8) = w; } }
    __syncthreads();
}
DI void phase0_weights(const PV& p, unsigned char* shm) {
    float* tile = (float*)shm;
    constexpr int PER = 160 + 64 + 352 + 176 + 4;
    for (int it = blockIdx.x; it < DEPTH * PER; it += gridDim.x) {
        const int l = it / PER; int j = it - l * PER;
        if (j < 160) { conv_tile<256>(p.w_in() + (size_t)l * 1024 * 2444, 2444, 1024, (j & 3) * 256, (j >> 2) * 64, -1, (bf16_t*)(p.ws() + WS_WIN + l * SZ_WIN), tile, p.ln_pre_mix() + (size_t)l * 1024); continue; }
        j -= 160;
        if (j < 64) { conv_tile<256>(p.w_out() + (size_t)l * 1024 * 1024, 1024, 1024, (j & 3) * 256, (j >> 2) * 64, (j >> 2) * 64, (bf16_t*)(p.ws() + WS_WOUT + l * SZ_WOUT), tile); continue; }
        j -= 64;
        if (j < 352) { const int n0 = (j >> 2) * 64, t256 = n0 >> 8, within = n0 & 255;
            const float* src = (within < 128 ? p.w_gate() : p.w_up()) + (size_t)l * 1024 * DFF;
            conv_tile<256>(src, DFF, 1024, (j & 3) * 256, n0, 128 * t256 + (within & 127), (bf16_t*)(p.ws() + WS_WGU + l * SZ_WGU), tile, p.ln_pre_ffn() + (size_t)l * 1024); continue; }
        j -= 352;
        if (j < 176) { const int nt = j / 11, kt = j - nt * 11; conv_tile<256>(p.w_down() + (size_t)l * DFF * 1024, 1024, DFF, kt * 256, nt * 64, nt * 64, (bf16_t*)(p.ws() + WS_WDN + l * SZ_WDN), tile); continue; }
        j -= 176;
        conv_tile<64>(p.pool_w() + (size_t)(l * 4 + j) * 4096, 64, 64, 0, 0, 0, (bf16_t*)(p.ws() + WS_PWT) + (size_t)(l * 4 + j) * 4096, tile);
    }
}

DI const float* row_src(const PV& p, int r) {
    if (r < MP) { const int b = r / TP, t = r - b * TP; return t < NMETA ? p.meta() + (size_t)t * 1024 : p.x_prompt() + ((size_t)b * SEQ + (t - NMETA)) * 1024; }
    return p.x_sample() + (size_t)(r - MP) * 1024;
}
DI f32x4 bf4(u32x2 w) { return (f32x4){bf_lo(w.x), bf_hi(w.x), bf_lo(w.y), bf_hi(w.y)}; }
DI void row_finish(const PV& p, int r, int lane, int mode, bool final, const f32x4 (&xo)[4], const f32x4 (&o)[4], const f32x4 (&gp)[4], bf16_t* XB, float* RSTD) {
    f32x4 x[4];
    if (mode) {
        float ss = 0.f;
#pragma unroll
        for (int j = 0; j < 4; ++j) ss += o[j][0] * o[j][0] + o[j][1] * o[j][1] + o[j][2] * o[j][2] + o[j][3] * o[j][3];
        ss = wave_sum(ss); const float rs = rsqrtf(ss * (1.f / 1024.f) + EPS);
#pragma unroll
        for (int j = 0; j < 4; ++j) x[j] = xo[j] + o[j] * rs * gp[j];
    } else {
#pragma unroll
        for (int j = 0; j < 4; ++j) x[j] = xo[j];
    }
    if (final) {
        float* dst = nullptr;
        if (r < MP) { const int b = r / TP, t = r - b * TP; if (t >= NMETA) dst = p.out() + OFF_Y + ((size_t)b * SEQ + (t - NMETA)) * 1024; }
        else dst = p.out() + OFF_YS + (size_t)(r - MP) * 1024;
        if (dst) {
#pragma unroll
            for (int j = 0; j < 4; ++j) *(f32x4*)(dst + 4 * (lane + 64 * j)) = x[j];
        }
    } else {
        float ss = 0.f;
#pragma unroll
        for (int j = 0; j < 4; ++j) ss += x[j][0] * x[j][0] + x[j][1] * x[j][1] + x[j][2] * x[j][2] + x[j][3] * x[j][3];
        ss = wave_sum(ss);
        if (lane == 0) RSTD[r] = rsqrtf(ss * (1.f / 1024.f) + EPS);
#pragma unroll
        for (int j = 0; j < 4; ++j) { u32x2 w = {pack2(x[j][0], x[j][1]), pack2(x[j][2], x[j][3])}; *(u32x2*)(XB + (size_t)r * 1024 + 4 * (lane + 64 * j)) = w; }
    }
}
DI void row_phase(const PV& p, int mode, const float* gpost, bool final, int nsplit, bool dry = false) {
    int tid_ = threadIdx.x; asm volatile("" : "+v"(tid_));
    const int lane = tid_ & 63, gw = blockIdx.x * 8 + (tid_ >> 6), nw = gridDim.x * 8;
    bf16_t* XB = (bf16_t*)(p.ws() + WS_H); const bf16_t* OUTB = (const bf16_t*)(p.ws() + WS_OUT); const float* PART = (const float*)(p.ws() + WS_PART); float* RSTD = (float*)(p.ws() + WS_RSTD);
    bf16_t* XW = dry ? (bf16_t*)(p.ws() + WS_X) : XB; float* RW = dry ? (float*)(p.ws() + WS_X + (size_t)MPAD * 2048) : RSTD;
    f32x4 gp[4];
#pragma unroll
    for (int j = 0; j < 4; ++j) gp[j] = mode ? *(const f32x4*)(gpost + 4 * (lane + 64 * j)) : (f32x4){0.f, 0.f, 0.f, 0.f};
    for (int r0 = gw; r0 < MMAIN; r0 += 4 * nw) {
        if (mode) {
            u32x2 xr[4][4], orr[4][4];
#pragma unroll
            for (int k = 0; k < 4; ++k) { const int r = r0 + k * nw < MMAIN ? r0 + k * nw : r0;
#pragma unroll
                for (int j = 0; j < 4; ++j) { xr[k][j] = *(const u32x2*)(XB + (size_t)r * 1024 + 4 * (lane + 64 * j)); orr[k][j] = *(const u32x2*)(OUTB + (size_t)r * 1024 + 4 * (lane + 64 * j)); } }
#pragma unroll
            for (int k = 0; k < 4; ++k) { const int r = r0 + k * nw;
                if (r < MMAIN) { f32x4 xo[4], o[4];
#pragma unroll
                    for (int j = 0; j < 4; ++j) { xo[j] = bf4(xr[k][j]); o[j] = bf4(orr[k][j]); }
                    row_finish(p, r, lane, 1, final, xo, o, gp, XW, RW); } }
        } else {
            f32x4 xf[4][4];
#pragma unroll
            for (int k = 0; k < 4; ++k) { const int r = r0 + k * nw < MMAIN ? r0 + k * nw : r0; const float* src = row_src(p, r);
#pragma unroll
                for (int j = 0; j < 4; ++j) xf[k][j] = *(const f32x4*)(src + 4 * (lane + 64 * j)); }
#pragma unroll
            for (int k = 0; k < 4; ++k) { const int r = r0 + k * nw; if (r < MMAIN) row_finish(p, r, lane, 0, false, xf[k], gp, gp, XW, RW); }
        }
    }
    for (int r = MMAIN + gw; r < MTOT; r += nw) {
        f32x4 xo[4], o[4];
        if (mode) {
            const bf16_t* pp = (const bf16_t*)PART + (size_t)(r - MMAIN) * 1024 + 4 * lane;
#pragma unroll
            for (int j = 0; j < 4; ++j) { xo[j] = bf4(*(const u32x2*)(XB + (size_t)r * 1024 + 4 * (lane + 64 * j))); o[j] = (f32x4){0.f, 0.f, 0.f, 0.f}; }
#pragma unroll 1
            for (int s0 = 0; s0 < nsplit; s0 += 4) {
                f32x4 t[4][4];
#pragma unroll
                for (int s = 0; s < 4; ++s) { const int ss = s0 + s < nsplit ? s0 + s : nsplit - 1;
#pragma unroll
                    for (int j = 0; j < 4; ++j) t[s][j] = bf4(*(const u32x2*)(pp + (size_t)ss * MTAILP * 1024 + 256 * j)); }
#pragma unroll
                for (int s = 0; s < 4; ++s) { const float wgt = s0 + s < nsplit ? 1.f : 0.f;
#pragma unroll
                    for (int j = 0; j < 4; ++j) o[j] += t[s][j] * wgt; }
            }
        } else {
            const float* src = row_src(p, r);
#pragma unroll
            for (int j = 0; j < 4; ++j) { xo[j] = *(const f32x4*)(src + 4 * (lane + 64 * j)); o[j] = (f32x4){0.f, 0.f, 0.f, 0.f}; }
        }
        row_finish(p, r, lane, mode, final, xo, o, gp, XW, RW);
    }
}

struct EpiOutB {
    static constexpr bool PERM = true, AFTER_DRAIN = false;
    bf16_t* C; float* part;
    DI void operator()(const f32x4 (&acc)[2][2][4][2], const pg8::Unit& u, int wr, int wc, int fr, int fq) const {
        const int row0 = u.pm * 256 + wr * 64 + fr, col0 = u.pn * 256 + wc * 32 + 8 * fq;
        if (u.slice < 0) {
#pragma unroll
            for (int ai = 0; ai < 2; ++ai)
#pragma unroll
                for (int m = 0; m < 4; ++m)
#pragma unroll
                    for (int bj = 0; bj < 2; ++bj) { const f32x4 v0 = acc[ai][bj][m][0], v1 = acc[ai][bj][m][1];
                        u32x4 w = {pack2(v0[0], v0[1]), pack2(v0[2], v0[3]), pack2(v1[0], v1[1]), pack2(v1[2], v1[3])};
                        *(u32x4*)(C + (size_t)(row0 + ai * 128 + m * 16) * 1024 + col0 + bj * 128) = w; }
        } else {
            bf16_t* base = (bf16_t*)part + ((size_t)u.slice * MTAILP + (row0 - MMAIN)) * 1024 + col0;
#pragma unroll
            for (int ai = 0; ai < 2; ++ai)
#pragma unroll
                for (int m = 0; m < 4; ++m)
#pragma unroll
                    for (int bj = 0; bj < 2; ++bj) { const f32x4 v0 = acc[ai][bj][m][0], v1 = acc[ai][bj][m][1];
                        u32x4 w = {pack2(v0[0], v0[1]), pack2(v0[2], v0[3]), pack2(v1[0], v1[1]), pack2(v1[2], v1[3])};
                        *(u32x4*)(base + (size_t)(ai * 128 + m * 16) * 1024 + bj * 128) = w; }
        }
    }
};
struct SplitOrder {
    int S, ntMain, G, c;
    DI bool next(int i, pg8::Unit& u) const {
        long L = (long)i * G + c;
        if (L < 256) { int l = (int)L; if (G == 256) { const int x = l & 7, j = l >> 3; u.pm = 8 * x + (j >> 2); u.pn = j & 3; } else { u.pm = l >> 2; u.pn = l & 3; }
            u.nt = ntMain; u.koff = 0; u.slice = -1; return true; }
        L -= 256; if (L >= 20 * S) return false;
        const int l = (int)L, s = l % S, tt = l / S; u.pm = 64 + (tt >> 2); u.pn = tt & 3; u.nt = 4; u.koff = s * 256; u.slice = s; return true;
    }
    DI void a_ready(const pg8::Unit&) const {}
    DI void done(const pg8::Unit&) const {}
};
struct EpiGU {
    static constexpr bool PERM = true, AFTER_DRAIN = false;
    bf16_t* O; const float* rstd;
    DI void operator()(const f32x4 (&acc)[2][2][4][2], const pg8::Unit& u, int wr, int wc, int fr, int fq) const {
        const int row0 = u.pm * 256 + wr * 64 + fr, col0 = u.pn * 128 + wc * 32 + 8 * fq;
#pragma unroll
        for (int ai = 0; ai < 2; ++ai)
#pragma unroll
            for (int m = 0; m < 4; ++m) {
                const float rs = rstd[row0 + ai * 128 + m * 16];
                const f32x4 g0 = acc[ai][0][m][0] * rs, g1 = acc[ai][0][m][1] * rs, u0 = acc[ai][1][m][0] * rs, u1 = acc[ai][1][m][1] * rs;
                u32x4 w = {pack2(siluf(g0[0]) * u0[0], siluf(g0[1]) * u0[1]), pack2(siluf(g0[2]) * u0[2], siluf(g0[3]) * u0[3]),
                           pack2(siluf(g1[0]) * u1[0], siluf(g1[1]) * u1[1]), pack2(siluf(g1[2]) * u1[2], siluf(g1[3]) * u1[3])};
                *(u32x4*)(O + (size_t)(row0 + ai * 128 + m * 16) * DFF + col0) = w;
            }
    }
};
DI float log_sigmoid(float x) { return fminf(x, 0.f) - log1pf(expf(-fabsf(x))); }
DI float softplusf(float x) { return fmaxf(x, 0.f) + log1pf(expf(-fabsf(x))); }
struct EpiIn {
    static constexpr bool PERM = true, AFTER_DRAIN = false;
    bf16_t* proj; bf16_t* vt; float* dtb; const float* fbias; const float* dtbias; const float* rstd;
    float *kp_, *ks_, *vp_, *vs_, *lp_, *ls_, *pp_, *ps_, *cp_, *cs_;
    DI void operator()(const f32x4 (&acc)[2][2][4][2], const pg8::Unit& u, int wr, int wc, int fr, int fq) const {
        unsigned long long a0 = (unsigned long long)kp_, a1 = (unsigned long long)ks_, a2 = (unsigned long long)vp_, a3 = (unsigned long long)vs_, a4 = (unsigned long long)lp_,
                           a5 = (unsigned long long)ls_, a6 = (unsigned long long)pp_, a7 = (unsigned long long)ps_, a8 = (unsigned long long)cp_, a9 = (unsigned long long)cs_;
        asm volatile("" : "+s"(a0), "+s"(a1), "+s"(a2), "+s"(a3), "+s"(a4)); asm volatile("" : "+s"(a5), "+s"(a6), "+s"(a7), "+s"(a8), "+s"(a9));
        float *kp = AS_G(a0), *ks = AS_G(a1), *vp = AS_G(a2), *vs = AS_G(a3), *lp = AS_G(a4), *ls = AS_G(a5), *pp = AS_G(a6), *ps = AS_G(a7), *cp = AS_G(a8), *cs = AS_G(a9);
#pragma unroll
        for (int ai = 0; ai < 2; ++ai)
#pragma unroll
            for (int m = 0; m < 4; ++m) {
                const int r = u.pm * 256 + ai * 128 + wr * 64 + m * 16 + fr;
                const bool valid = r < MTOT, isP = r < MP;
                int b, t; if (isP) { b = r / TP; t = r - b * TP; } else { const int rs = r - MP; b = rs >> 5; t = rs & 31; }
                const int rr = isP ? r : r - MP; const float rsr = rstd[r];
#pragma unroll
                for (int bj = 0; bj < 2; ++bj) {
                    const int cb = u.pn * 256 + bj * 128, c0 = cb + wc * 32 + fq * 8;
                    const f32x4 v0 = acc[ai][bj][m][0] * rsr, v1 = acc[ai][bj][m][1] * rsr;
                    if (cb < CF_) {
                        const float sc = cb < CK_ ? QSCALE : 1.f;
                        u32x4 w = {pack2(v0[0] * sc, v0[1] * sc), pack2(v0[2] * sc, v0[3] * sc), pack2(v1[0] * sc, v1[1] * sc), pack2(v1[2] * sc, v1[3] * sc)};
                        *(u32x4*)(proj + (size_t)r * NPROJ + c0) = w;
                        if (valid) {
                            if (cb >= CK_ && cb < CV_) {
                            } else if (cb >= CV_ && cb < CU_) {
                            } else if (cb >= CU_ && cb < CZ_) {
                                const int tt = isP ? t - (TP - 15) : t - (DS - 15);
                                if (tt >= 0) { float* d = (isP ? pp : ps) + (size_t)(b * 15 + tt) * 256 + (c0 - CU_); *(f32x4*)d = v0; *(f32x4*)(d + 4) = v1; }
                            } else if (cb >= CX_) {
                                const int tt = isP ? t - (TP - 3) : t - (DS - 3);
                                if (tt >= 0) { float* d = (isP ? cp : cs) + (size_t)(b * 3 + tt) * 640 + (c0 - CX_); *(f32x4*)d = v0; *(f32x4*)(d + 4) = v1; }
                            }
                        }
                    } else if (cb == CF_) {
                        if (valid && c0 == CF_) {
                            float* d = (isP ? lp : ls) + (size_t)rr * 6;
                            d[0] = log_sigmoid(v0[0] + fbias[0]); d[1] = log_sigmoid(v0[1] + fbias[1]); d[2] = log_sigmoid(v0[2] + fbias[2]); d[3] = log_sigmoid(v0[3] + fbias[3]);
                            d[4] = log_sigmoid(v1[0] + fbias[4]); d[5] = log_sigmoid(v1[1] + fbias[5]);
                        }
                        if (c0 == CDT_) {
                            float* d = dtb + (size_t)r * 8;
                            d[0] = softplusf(v0[0] + dtbias[0]); d[1] = softplusf(v0[1] + dtbias[1]); d[2] = softplusf(v0[2] + dtbias[2]); d[3] = softplusf(v0[3] + dtbias[3]);
                            d[4] = softplusf(v1[0] + dtbias[4]); d[5] = softplusf(v1[1] + dtbias[5]);
                        }
                    }
                }
                __builtin_amdgcn_sched_barrier(0);
            }
    }
};
constexpr int ABUF = 18688;
DI void attn_prompt(const PV& p, int l, int b, int h, int qi, unsigned char* shm) {
    int tid_ = threadIdx.x; asm volatile("" : "+v"(tid_)); const int tid = tid_, wid = tid >> 6, lane = tid & 63, col = lane & 31, hi = lane >> 5;
    const bf16_t* PROJ = (const bf16_t*)(p.ws() + WS_PROJ); const bf16_t* VT = (const bf16_t*)(p.ws() + WS_VT); bf16_t* MIX = (bf16_t*)(p.ws() + WS_MIX);
    const float* LOGF = p.out() + OFF_LP + (size_t)l * MP * 6;
    const int q0 = qi == 0 ? 0 : 16 + 256 * (qi - 1), nrows = qi == 0 ? 16 : 256, kend = q0 + nrows, nt = (kend + 63) >> 6;
    const int qw0 = q0 + 32 * wid; const bool wact = 32 * wid < nrows; const int qrow = qw0 + col;
    const size_t rowbase = (size_t)b * TP;
    bf16x8 qf[4];
    { const bf16_t* qp = PROJ + (rowbase + (qrow < TP ? qrow : TP - 1)) * NPROJ + h * 64 + 8 * hi;
#pragma unroll
      for (int ks = 0; ks < 4; ++ks) qf[ks] = *(const bf16x8*)(qp + 16 * ks); }
    const int lr = tid >> 3, lseg = tid & 7;
    const bf16_t* kg = PROJ + CK_ + h * 64 + lseg * 8;
    const int vkey = tid & 63, vds = tid >> 6;
    const bf16_t* vg = PROJ + CV_ + h * 64 + vds * 8;
    const int vpos = (vkey & ~15) + 8 * ((vkey >> 2) & 1) + 4 * ((vkey >> 3) & 1) + (vkey & 3);
    float carry = 0.f; u32x4 kreg, vreg; float lfv = 0.f;
#define ATT_GLOAD(K0) do { const int key_ = (K0) + lr; kreg = *(const u32x4*)(kg + (rowbase + (key_ < TP ? key_ : TP - 1)) * NPROJ); { const int vk_ = (K0) + vkey; vreg = *(const u32x4*)(vg + (rowbase + (vk_ < TP ? vk_ : TP - 1)) * NPROJ); } \
        if (wid == 0) { const int kk_ = (K0) + lane; lfv = kk_ < TP ? LOGF[(rowbase + kk_) * 6 + h] : 0.f; } } while (0)
#define ATT_LSTORE(S) do { unsigned char* B_ = shm + (S) * ABUF; *(u32x4*)(B_ + lr * 144 + lseg * 16) = kreg; { bf16_t* v_ = (bf16_t*)(B_ + 9216) + (vds * 8) * 72 + vpos; v_[0] = (bf16_t)(vreg.x & 0xffffu); v_[72] = (bf16_t)(vreg.x >> 16); v_[144] = (bf16_t)(vreg.y & 0xffffu); v_[216] = (bf16_t)(vreg.y >> 16); \
          v_[288] = (bf16_t)(vreg.z & 0xffffu); v_[360] = (bf16_t)(vreg.z >> 16); v_[432] = (bf16_t)(vreg.w & 0xffffu); v_[504] = (bf16_t)(vreg.w >> 16); } \
        if (wid == 0) { float v_ = wave_scan_incl(lfv, lane) + carry; ((float*)(B_ + 18432))[lane] = -v_ * LOG2E; carry = __shfl(v_, 63); } } while (0)
    ATT_GLOAD(0); ATT_LSTORE(0); __syncthreads();
    f32x16 o0, o1;
#pragma unroll
    for (int i = 0; i < 16; ++i) { o0[i] = 0.f; o1[i] = 0.f; }
    float m = -1e30f, lsum = 0.f;
    for (int t = 0; t < nt; ++t) {
        const int k0 = t * 64; const bool more = t + 1 < nt;
        if (more) ATT_GLOAD(k0 + 64);
        if (wact && k0 <= qw0 + 31) {
            const unsigned char* B = shm + (t & 1) * ABUF;
            f32x16 s0, s1;
            const float* cbp = (const float*)(B + 18432);
#pragma unroll
            for (int g = 0; g < 4; ++g) { const f32x4 c0 = *(const f32x4*)(cbp + 8 * g + 4 * hi), c1 = *(const f32x4*)(cbp + 32 + 8 * g + 4 * hi);
#pragma unroll
                for (int j = 0; j < 4; ++j) { s0[4 * g + j] = c0[j]; s1[4 * g + j] = c1[j]; } }
#pragma unroll
            for (int ks = 0; ks < 4; ++ks) {
                const bf16x8 a0 = *(const bf16x8*)(B + col * 144 + (16 * ks + 8 * hi) * 2), a1 = *(const bf16x8*)(B + (32 + col) * 144 + (16 * ks + 8 * hi) * 2);
                s0 = MFMA32(a0, qf[ks], s0); s1 = MFMA32(a1, qf[ks], s1);
            }
            if (k0 + 63 > qw0) {
#pragma unroll
                for (int i = 0; i < 16; ++i) { const int key = k0 + crow(i, hi); if (key > qrow) s0[i] = -INFINITY; if (key + 32 > qrow) s1[i] = -INFINITY; }
            }
            float mx = fmaxf(s0[0], s0[1]);
#pragma unroll
            for (int i = 2; i < 16; i += 2) mx = fmaxf(fmaxf(mx, s0[i]), s0[i + 1]);
#pragma unroll
            for (int i = 0; i < 16; i += 2) mx = fmaxf(fmaxf(mx, s1[i]), s1[i + 1]);
            mx = fmaxf(mx, __shfl_xor(mx, 32));
            const float mn = fmaxf(m, mx), alpha = ex2(m - mn); m = mn;
            typedef float f32x2_t __attribute__((ext_vector_type(2)));
            const f32x2_t mn2 = {mn, mn}; f32x2_t ps2 = {0.f, 0.f};
#pragma unroll
            for (int i = 0; i < 16; i += 2) {
                f32x2_t a = (f32x2_t){s0[i], s0[i + 1]} - mn2, b2 = (f32x2_t){s1[i], s1[i + 1]} - mn2;
                a.x = ex2(a.x); a.y = ex2(a.y); b2.x = ex2(b2.x); b2.y = ex2(b2.y);
                s0[i] = a.x; s0[i + 1] = a.y; s1[i] = b2.x; s1[i + 1] = b2.y; ps2 += a + b2;
            }
            const float ps = ps2.x + ps2.y;
            lsum = lsum * alpha + ps;
#pragma unroll
            for (int i = 0; i < 16; ++i) { o0[i] *= alpha; o1[i] *= alpha; }
#pragma unroll
            for (int kb = 0; kb < 2; ++kb)
#pragma unroll
                for (int s = 0; s < 2; ++s) {
                    const bf16x8 pf = kb == 0 ? pack8(s0[8 * s], s0[8 * s + 1], s0[8 * s + 2], s0[8 * s + 3], s0[8 * s + 4], s0[8 * s + 5], s0[8 * s + 6], s0[8 * s + 7])
                                              : pack8(s1[8 * s], s1[8 * s + 1], s1[8 * s + 2], s1[8 * s + 3], s1[8 * s + 4], s1[8 * s + 5], s1[8 * s + 6], s1[8 * s + 7]);
                    const unsigned char* vb = B + 9216 + (kb * 32 + 16 * s + 8 * hi) * 2;
                    const bf16x8 a0 = *(const bf16x8*)(vb + col * 144), a1 = *(const bf16x8*)(vb + (32 + col) * 144);
                    o0 = MFMA32(a0, pf, o0); o1 = MFMA32(a1, pf, o1);
                }
        }
        if (more) ATT_LSTORE((t + 1) & 1);
        __syncthreads();
    }
#undef ATT_GLOAD
#undef ATT_LSTORE
    if (wact) {
        const float lt = lsum + __shfl_xor(lsum, 32); const float inv = 1.f / lt;
        if (qrow < kend) { bf16_t* op = MIX + (rowbase + qrow) * 1024 + h * 64;
#pragma unroll
            for (int g = 0; g < 4; ++g) {
                u32x2 w0 = {pack2(o0[4 * g] * inv, o0[4 * g + 1] * inv), pack2(o0[4 * g + 2] * inv, o0[4 * g + 3] * inv)};
                u32x2 w1 = {pack2(o1[4 * g] * inv, o1[4 * g + 1] * inv), pack2(o1[4 * g + 2] * inv, o1[4 * g + 3] * inv)};
                *(u32x2*)(op + 8 * g + 4 * hi) = w0; *(u32x2*)(op + 32 + 8 * g + 4 * hi) = w1;
            } }
    }
}

DI bool attn_prompt_fast(const PV& p, int l, int b, int h, int qi, unsigned char* shm) {
    int tid_ = threadIdx.x; asm volatile("" : "+v"(tid_)); const int tid = tid_, wid = tid >> 6, lane = tid & 63, col = lane & 31, hi = lane >> 5;
    const bf16_t* PROJ = (const bf16_t*)(p.ws() + WS_PROJ); const bf16_t* VT = (const bf16_t*)(p.ws() + WS_VT); bf16_t* MIX = (bf16_t*)(p.ws() + WS_MIX);
    const float* LOGF = p.out() + OFF_LP + (size_t)l * MP * 6;
    int* oflag = (int*)(shm + 131072 + 32);
    const int q0 = qi == 0 ? 0 : 16 + 256 * (qi - 1), nrows = qi == 0 ? 16 : 256, kend = q0 + nrows, nt = (kend + 63) >> 6;
    const int qw0 = q0 + 32 * wid; const bool wact = 32 * wid < nrows; const int qrow = qw0 + col;
    const size_t rowbase = (size_t)b * TP;
    if (tid == 0) *oflag = 0;
    bf16x8 qf[4];
    { const bf16_t* qp = PROJ + (rowbase + (qrow < TP ? qrow : TP - 1)) * NPROJ + h * 64 + 8 * hi;
#pragma unroll
      for (int ks = 0; ks < 4; ++ks) qf[ks] = *(const bf16x8*)(qp + 16 * ks); }
    const int lr = tid >> 3, lseg = tid & 7;
    const bf16_t* kg = PROJ + CK_ + h * 64 + lseg * 8;
    const int vkey = tid & 63, vds = tid >> 6;
    const bf16_t* vg = PROJ + CV_ + h * 64 + vds * 8;
    const int vpos = (vkey & ~15) + 8 * ((vkey >> 2) & 1) + 4 * ((vkey >> 3) & 1) + (vkey & 3);
    float carry = 0.f; u32x4 kreg, vreg; float lfv = 0.f;
#define ATF_GLOAD(K0) do { const int key_ = (K0) + lr; kreg = *(const u32x4*)(kg + (rowbase + (key_ < TP ? key_ : TP - 1)) * NPROJ); { const int vk_ = (K0) + vkey; vreg = *(const u32x4*)(vg + (rowbase + (vk_ < TP ? vk_ : TP - 1)) * NPROJ); } \
        if (wid == 0) { const int kk_ = (K0) + lane; lfv = kk_ < TP ? LOGF[(rowbase + kk_) * 6 + h] : 0.f; } } while (0)
#define ATF_LSTORE(S) do { unsigned char* B_ = shm + (S) * ABUF; *(u32x4*)(B_ + lr * 144 + lseg * 16) = kreg; { bf16_t* v_ = (bf16_t*)(B_ + 9216) + (vds * 8) * 72 + vpos; v_[0] = (bf16_t)(vreg.x & 0xffffu); v_[72] = (bf16_t)(vreg.x >> 16); v_[144] = (bf16_t)(vreg.y & 0xffffu); v_[216] = (bf16_t)(vreg.y >> 16); \
          v_[288] = (bf16_t)(vreg.z & 0xffffu); v_[360] = (bf16_t)(vreg.z >> 16); v_[432] = (bf16_t)(vreg.w & 0xffffu); v_[504] = (bf16_t)(vreg.w >> 16); } \
        if (wid == 0) { const float in_ = wave_scan_incl(lfv, lane); const float tot_ = __shfl(in_, 63); ((float*)(B_ + 18432))[lane] = (carry + (tot_ - in_)) * LOG2E; carry += tot_; } } while (0)
    ATF_GLOAD(64 * (nt - 1)); ATF_LSTORE((nt - 1) & 1); __syncthreads();
    f32x16 o0, o1;
#pragma unroll
    for (int i = 0; i < 16; ++i) { o0[i] = 0.f; o1[i] = 0.f; }
    float mref = 0.f, l0 = 0.f, l1 = 0.f, l2 = 0.f, l3 = 0.f;
    for (int t = nt - 1; t >= 0; --t) {
        const int k0 = t * 64; const bool more = t > 0;
        if (more) ATF_GLOAD(k0 - 64);
        if (wact && k0 <= qw0 + 31) {
            const unsigned char* B = shm + (t & 1) * ABUF;
            const float* cbp = (const float*)(B + 18432);
            const bool diag = k0 + 63 > qw0;
            if (diag) { const int d = qrow - k0; if (d >= 0 && d < 64) mref = cbp[d]; }
            f32x16 s0, s1;
#pragma unroll
            for (int g = 0; g < 4; ++g) { const f32x4 c0 = *(const f32x4*)(cbp + 8 * g + 4 * hi), c1 = *(const f32x4*)(cbp + 32 + 8 * g + 4 * hi);
#pragma unroll
                for (int j = 0; j < 4; ++j) { s0[4 * g + j] = c0[j] - mref; s1[4 * g + j] = c1[j] - mref; } }
#pragma unroll
            for (int ks = 0; ks < 4; ++ks) {
                const bf16x8 a0 = *(const bf16x8*)(B + col * 144 + (16 * ks + 8 * hi) * 2), a1 = *(const bf16x8*)(B + (32 + col) * 144 + (16 * ks + 8 * hi) * 2);
                s0 = MFMA32(a0, qf[ks], s0); s1 = MFMA32(a1, qf[ks], s1);
            }
            if (diag) {
#pragma unroll
                for (int i = 0; i < 16; ++i) { const int key = k0 + crow(i, hi); if (key > qrow) s0[i] = -INFINITY; if (key + 32 > qrow) s1[i] = -INFINITY; }
            }
#pragma unroll
            for (int i = 0; i < 16; ++i) { s0[i] = ex2(s0[i]); s1[i] = ex2(s1[i]); }
#pragma unroll
            for (int i = 0; i < 16; i += 2) { l0 += s0[i]; l1 += s1[i + 1]; l2 += s1[i]; l3 += s0[i + 1]; }
#pragma unroll
            for (int kb = 0; kb < 2; ++kb)
#pragma unroll
                for (int s = 0; s < 2; ++s) {
                    const bf16x8 pf = kb == 0 ? pack8(s0[8 * s], s0[8 * s + 1], s0[8 * s + 2], s0[8 * s + 3], s0[8 * s + 4], s0[8 * s + 5], s0[8 * s + 6], s0[8 * s + 7])
                                              : pack8(s1[8 * s], s1[8 * s + 1], s1[8 * s + 2], s1[8 * s + 3], s1[8 * s + 4], s1[8 * s + 5], s1[8 * s + 6], s1[8 * s + 7]);
                    const unsigned char* vb = B + 9216 + (kb * 32 + 16 * s + 8 * hi) * 2;
                    const bf16x8 a0 = *(const bf16x8*)(vb + col * 144), a1 = *(const bf16x8*)(vb + (32 + col) * 144);
                    o0 = MFMA32(a0, pf, o0); o1 = MFMA32(a1, pf, o1);
                }
        }
        if (more) ATF_LSTORE((t - 1) & 1);
        __syncthreads();
    }
#undef ATF_GLOAD
#undef ATF_LSTORE
    if (wact) {
        const float lsum = (l0 + l1) + (l2 + l3);
        const float lt = lsum + __shfl_xor(lsum, 32); const float inv = 1.f / lt;
        if (qrow < kend) {
            if (!(lt < 3.0e38f) || !(lt > 0.f)) *oflag = 1;
            bf16_t* op = MIX + (rowbase + qrow) * 1024 + h * 64;
#pragma unroll
            for (int g = 0; g < 4; ++g) {
                u32x2 w0 = {pack2(o0[4 * g] * inv, o0[4 * g + 1] * inv), pack2(o0[4 * g + 2] * inv, o0[4 * g + 3] * inv)};
                u32x2 w1 = {pack2(o1[4 * g] * inv, o1[4 * g + 1] * inv), pack2(o1[4 * g + 2] * inv, o1[4 * g + 3] * inv)};
                *(u32x2*)(op + 8 * g + 4 * hi) = w0; *(u32x2*)(op + 32 + 8 * g + 4 * hi) = w1;
            } }
    }
    __syncthreads();
    return *oflag != 0;
}

DI void attn_sample(const PV& p, int l, int b, int h, unsigned char* shm) {
    int tid_ = threadIdx.x; asm volatile("" : "+v"(tid_)); const int tid = tid_, wid = tid >> 6, lane = tid & 63, col = lane & 31, hi = lane >> 5;
    const bf16_t* PROJ = (const bf16_t*)(p.ws() + WS_PROJ); bf16_t* MIX = (bf16_t*)(p.ws() + WS_MIX);
    float* cbs = (float*)shm; float* OW = (float*)(shm + 4352); float* ML = (float*)(shm + 4352 + 65536);
    const size_t cbase = (size_t)(l * DB + b) * PAST; const size_t rbase = (size_t)MP + b * 32;
    if (wid == 0) {
        const float* cl = p.cache_logf() + cbase * 6 + h; const float* lfn = p.out() + OFF_LS + ((size_t)l * MS + b * 32) * 6 + h;
        float v[17];
#pragma unroll
        for (int i = 0; i < 17; ++i) { const int idx = i * 64 + lane; v[i] = idx < PAST ? cl[(size_t)idx * 6] : (idx < PAST + DS ? lfn[(size_t)(idx - PAST) * 6] : 0.f); }
        float carry = 0.f;
#pragma unroll
        for (int i = 0; i < 17; ++i) { const int idx = i * 64 + lane; const float s = wave_scan_incl(v[i], lane) + carry; if (idx < PAST + DS) cbs[idx] = -s * LOG2E; carry = __shfl(s, 63); }
    }
    __syncthreads();
    bf16x8 qf[4];
    { const bf16_t* qp = PROJ + (rbase + col) * NPROJ + h * 64 + 8 * hi;
#pragma unroll
      for (int ks = 0; ks < 4; ++ks) qf[ks] = *(const bf16x8*)(qp + 16 * ks); }
    f32x16 o0, o1;
#pragma unroll
    for (int i = 0; i < 16; ++i) { o0[i] = 0.f; o1[i] = 0.f; }
    float m = -1e30f, lsum = 0.f;
    for (int tile = wid; tile < 33; tile += 8) {
        f32x16 s;
#pragma unroll
        for (int i = 0; i < 16; ++i) s[i] = 0.f;
        if (tile < 32) {
            const float* kp = p.cache_k() + (cbase + tile * 32 + col) * 384 + h * 64 + 8 * hi;
#pragma unroll
            for (int ks = 0; ks < 4; ++ks) { const f32x4 x0 = *(const f32x4*)(kp + 16 * ks), x1 = *(const f32x4*)(kp + 16 * ks + 4);
                s = MFMA32(pack8(x0[0], x0[1], x0[2], x0[3], x1[0], x1[1], x1[2], x1[3]), qf[ks], s); }
        } else {
            const bf16_t* kp = PROJ + (rbase + col) * NPROJ + CK_ + h * 64 + 8 * hi;
#pragma unroll
            for (int ks = 0; ks < 4; ++ks) s = MFMA32(*(const bf16x8*)(kp + 16 * ks), qf[ks], s);
        }
#pragma unroll
        for (int g = 0; g < 4; ++g) { const f32x4 c0 = *(const f32x4*)(cbs + tile * 32 + 8 * g + 4 * hi);
#pragma unroll
            for (int j = 0; j < 4; ++j) s[4 * g + j] += c0[j]; }
        if (tile == 32) {
#pragma unroll
            for (int i = 0; i < 16; ++i) if (crow(i, hi) > col) s[i] = -INFINITY;
        }
        float mx = s[0];
#pragma unroll
        for (int i = 1; i < 16; ++i) mx = fmaxf(mx, s[i]);
        mx = fmaxf(mx, __shfl_xor(mx, 32));
        const float mn = fmaxf(m, mx), alpha = ex2(m - mn); m = mn;
        float ps = 0.f;
#pragma unroll
        for (int i = 0; i < 16; ++i) { s[i] = ex2(s[i] - mn); ps += s[i]; }
        lsum = lsum * alpha + ps;
#pragma unroll
        for (int i = 0; i < 16; ++i) { o0[i] *= alpha; o1[i] *= alpha; }
#pragma unroll
        for (int ss = 0; ss < 2; ++ss) {
            const bf16x8 pf = pack8(s[8 * ss], s[8 * ss + 1], s[8 * ss + 2], s[8 * ss + 3], s[8 * ss + 4], s[8 * ss + 5], s[8 * ss + 6], s[8 * ss + 7]);
            bf16x8 a0, a1;
            if (tile < 32) {
                const float* vp = p.cache_v() + (cbase + tile * 32 + 16 * ss + 4 * hi) * 384 + h * 64 + col;
                a0 = pack8(vp[0], vp[384], vp[2 * 384], vp[3 * 384], vp[8 * 384], vp[9 * 384], vp[10 * 384], vp[11 * 384]);
                a1 = pack8(vp[32], vp[384 + 32], vp[2 * 384 + 32], vp[3 * 384 + 32], vp[8 * 384 + 32], vp[9 * 384 + 32], vp[10 * 384 + 32], vp[11 * 384 + 32]);
            } else {
                const bf16_t* vp = PROJ + (rbase + 16 * ss + 4 * hi) * NPROJ + CV_ + h * 64 + col;
                u32x4 w0 = {(unsigned)vp[0] | ((unsigned)vp[NPROJ] << 16), (unsigned)vp[2 * NPROJ] | ((unsigned)vp[3 * NPROJ] << 16),
                            (unsigned)vp[8 * NPROJ] | ((unsigned)vp[9 * NPROJ] << 16), (unsigned)vp[10 * NPROJ] | ((unsigned)vp[11 * NPROJ] << 16)};
                u32x4 w1 = {(unsigned)vp[32] | ((unsigned)vp[NPROJ + 32] << 16), (unsigned)vp[2 * NPROJ + 32] | ((unsigned)vp[3 * NPROJ + 32] << 16),
                            (unsigned)vp[8 * NPROJ + 32] | ((unsigned)vp[9 * NPROJ + 32] << 16), (unsigned)vp[10 * NPROJ + 32] | ((unsigned)vp[11 * NPROJ + 32] << 16)};
                a0 = __builtin_bit_cast(bf16x8, w0); a1 = __builtin_bit_cast(bf16x8, w1);
            }
            o0 = MFMA32(a0, pf, o0); o1 = MFMA32(a1, pf, o1);
        }
    }
    { const float lt = lsum + __shfl_xor(lsum, 32); float* Ow = OW + wid * 2048;
#pragma unroll
      for (int i = 0; i < 16; ++i) { Ow[crow(i, hi) * 32 + col] = o0[i]; Ow[(32 + crow(i, hi)) * 32 + col] = o1[i]; }
      if (hi == 0) { ML[(wid * 32 + col) * 2] = m; ML[(wid * 32 + col) * 2 + 1] = lt; } }
    __syncthreads();
    { const int q = tid & 31, dg = tid >> 5; float M = -1e30f;
#pragma unroll
      for (int w = 0; w < 8; ++w) M = fmaxf(M, ML[(w * 32 + q) * 2]);
      float L = 0.f, a0 = 0.f, a1 = 0.f, a2 = 0.f, a3 = 0.f;
#pragma unroll
      for (int w = 0; w < 8; ++w) { const float f = ex2(ML[(w * 32 + q) * 2] - M); L += ML[(w * 32 + q) * 2 + 1] * f; const float* Ow = OW + w * 2048 + (4 * dg) * 32 + q;
          a0 += Ow[0] * f; a1 += Ow[32] * f; a2 += Ow[64] * f; a3 += Ow[96] * f; }
      const float inv = 1.f / L; u32x2 w = {pack2(a0 * inv, a1 * inv), pack2(a2 * inv, a3 * inv)};
      *(u32x2*)(MIX + (rbase + q) * 1024 + h * 64 + 4 * dg) = w; }
}

constexpr int L_XT = 0, L_BM = 55296, L_BT = 73728, L_CM = 92160, L_DTS = 110592, L_ACS = 112128;
DI void ssd_a(const PV& p, int l, int grp, int b, int c, unsigned char* shm) {
    int tid_ = threadIdx.x; asm volatile("" : "+v"(tid_)); const int tid = tid_, wid = tid >> 6, lane = tid & 63, col = lane & 31, hi = lane >> 5;
    const bf16_t* PROJ = (const bf16_t*)(p.ws() + WS_PROJ); const float* DT = (const float*)(p.ws() + WS_DT);
    float* Y32 = (float*)(p.ws() + WS_Y32); bf16_t* CC = (bf16_t*)(p.ws() + WS_CC); float* ACSG = (float*)(p.ws() + WS_ACS); float* ST = (float*)(p.ws() + WS_ST);
    bf16_t* XT = (bf16_t*)(shm + L_XT); bf16_t* BM = (bf16_t*)(shm + L_BM); bf16_t* BT = (bf16_t*)(shm + L_BT); bf16_t* CM = (bf16_t*)(shm + L_CM);
    float* DTS = (float*)(shm + L_DTS); float* ACSL = (float*)(shm + L_ACS);
    const int t0 = grp == 0 ? 64 * c - 48 : 0, tlim = grp == 0 ? TP : DS;
    const size_t rbase = grp == 0 ? (size_t)b * TP : (size_t)MP + b * 32;
    if (wid < 6) {
        const int t = t0 + lane; const bool valid = t >= 0 && t < tlim;
        const float dt = valid ? DT[(rbase + t) * 8 + wid] : 0.f; const float a = -expf(p.a_log()[l * 6 + wid]);
        const float acs = wave_scan_incl(dt * a, lane);
        DTS[wid * 64 + lane] = dt; ACSL[wid * 64 + lane] = acs; if (valid) ACSG[(rbase + t) * 8 + wid] = acs;
    }
    const float* cw = p.conv_w() + (size_t)l * 4 * 640; const float* cbias = p.conv_b() + (size_t)l * 640;
    if (tid < 480) {
        const int ch = 4 * (tid % 160), rg = tid / 160, sb = rg * 22, se = sb + 22 < 64 ? sb + 22 : 64;
        const f32x4 w0 = *(const f32x4*)(cw + ch), w1 = *(const f32x4*)(cw + 640 + ch), w2 = *(const f32x4*)(cw + 1280 + ch), w3 = *(const f32x4*)(cw + 1920 + ch), bias4 = *(const f32x4*)(cbias + ch);
        u32x2 raw[25]; f32x4 pre[3];
#pragma unroll
        for (int i = 0; i < 25; ++i) { const int tt = t0 + sb - 3 + i; raw[i] = (u32x2){0u, 0u};
            if (tt >= 0 && tt < tlim && sb - 3 + i < 64) raw[i] = *(const u32x2*)(PROJ + (rbase + tt) * NPROJ + CX_ + ch); }
#pragma unroll
        for (int i = 0; i < 3; ++i) { const int tt = t0 + sb - 3 + i; pre[i] = (f32x4){0.f, 0.f, 0.f, 0.f};
            if (tt < 0 && grp == 1) pre[i] = *(const f32x4*)(p.state_conv() + ((size_t)(l * DB + b) * 3 + 3 + tt) * 640 + ch); }
        f32x4 xw[25];
#pragma unroll
        for (int i = 0; i < 25; ++i) { xw[i] = (f32x4){bf_lo(raw[i].x), bf_hi(raw[i].x), bf_lo(raw[i].y), bf_hi(raw[i].y)}; if (i < 3) xw[i] += pre[i]; }
#pragma unroll
        for (int r = 0; r < 22; ++r) {
            const int s = sb + r;
            if (s < se) {
                const int t = t0 + s; const bool valid = t >= 0 && t < tlim;
                const f32x4 a = bias4 + xw[r] * w0 + xw[r + 1] * w1 + xw[r + 2] * w2 + xw[r + 3] * w3;
                f32x4 v = {siluf(a[0]), siluf(a[1]), siluf(a[2]), siluf(a[3])};
                if (!valid) v = (f32x4){0.f, 0.f, 0.f, 0.f};
                if (ch < 384) { const int hh = ch >> 6, pp = ch & 63; bf16_t* d = XT + ((hh * 64 + pp) * 72 + s);
                    d[0] = f2bf(v[0]); d[72] = f2bf(v[1]); d[144] = f2bf(v[2]); d[216] = f2bf(v[3]); }
                else if (ch < 512) { const int g = (ch - 384) >> 6, n = (ch - 384) & 63; u32x2 w = {pack2(v[0], v[1]), pack2(v[2], v[3])};
                    *(u32x2*)(BM + (g * 64 + s) * 72 + n) = w; bf16_t* d = BT + ((g * 64 + n) * 72 + s);
                    d[0] = (bf16_t)(w.x & 0xffffu); d[72] = (bf16_t)(w.x >> 16); d[144] = (bf16_t)(w.y & 0xffffu); d[216] = (bf16_t)(w.y >> 16); }
                else { const int g = (ch - 512) >> 6, n = (ch - 512) & 63; u32x2 w = {pack2(v[0], v[1]), pack2(v[2], v[3])};
                    *(u32x2*)(CM + (g * 64 + s) * 72 + n) = w; if (valid) *(u32x2*)(CC + (rbase + t) * 128 + (ch - 512)) = w; }
            }
        }
    }
    __syncthreads();
    if (wid < 6) {
        const int h = wid, g = h / 3; const float Dh = p.d_skip()[l * 6 + h];
        const float* acsl = ACSL + h * 64; const float* dts = DTS + h * 64;
        const float acsq0 = acsl[col], acsq1 = acsl[32 + col], acs63 = acsl[63];
        const bf16_t* xt = XT + h * 64 * 72; const bf16_t* bm = BM + g * 64 * 72; const bf16_t* bt = BT + g * 64 * 72; const bf16_t* cm = CM + g * 64 * 72;
        f32x16 g00, g01, g11;
#pragma unroll
        for (int i = 0; i < 16; ++i) { g00[i] = 0.f; g01[i] = 0.f; g11[i] = 0.f; }
#pragma unroll
        for (int ks = 0; ks < 4; ++ks) {
            const int ko = 16 * ks + 8 * hi;
            const bf16x8 bs0 = *(const bf16x8*)(bm + col * 72 + ko), bs1 = *(const bf16x8*)(bm + (32 + col) * 72 + ko);
            const bf16x8 cq0 = *(const bf16x8*)(cm + col * 72 + ko), cq1 = *(const bf16x8*)(cm + (32 + col) * 72 + ko);
            g00 = MFMA32(bs0, cq0, g00); g01 = MFMA32(bs0, cq1, g01); g11 = MFMA32(bs1, cq1, g11);
        }
#pragma unroll
        for (int gq = 0; gq < 4; ++gq) {
            const f32x4 as0 = *(const f32x4*)(acsl + 8 * gq + 4 * hi), as1 = *(const f32x4*)(acsl + 32 + 8 * gq + 4 * hi);
            const f32x4 ds0 = *(const f32x4*)(dts + 8 * gq + 4 * hi), ds1 = *(const f32x4*)(dts + 32 + 8 * gq + 4 * hi);
#pragma unroll
            for (int j = 0; j < 4; ++j) { const int i = 4 * gq + j, s = 8 * gq + 4 * hi + j;
                g00[i] = s <= col ? g00[i] * __expf(acsq0 - as0[j]) * ds0[j] + (s == col ? Dh : 0.f) : 0.f;
                g01[i] = g01[i] * __expf(acsq1 - as0[j]) * ds0[j];
                g11[i] = s <= col ? g11[i] * __expf(acsq1 - as1[j]) * ds1[j] + (s == col ? Dh : 0.f) : 0.f; }
        }
        f32x16 y00, y10, y01, y11;
#pragma unroll
        for (int i = 0; i < 16; ++i) { y00[i] = 0.f; y10[i] = 0.f; y01[i] = 0.f; y11[i] = 0.f; }
#pragma unroll
        for (int ss = 0; ss < 2; ++ss) {
            const int so = 16 * ss + 4 * hi;
            const bf16x8 xa0 = cat8(*(const u32x2*)(xt + col * 72 + so), *(const u32x2*)(xt + col * 72 + so + 8));
            const bf16x8 xa1 = cat8(*(const u32x2*)(xt + (32 + col) * 72 + so), *(const u32x2*)(xt + (32 + col) * 72 + so + 8));
            const bf16x8 xb0 = cat8(*(const u32x2*)(xt + col * 72 + 32 + so), *(const u32x2*)(xt + col * 72 + 32 + so + 8));
            const bf16x8 xb1 = cat8(*(const u32x2*)(xt + (32 + col) * 72 + 32 + so), *(const u32x2*)(xt + (32 + col) * 72 + 32 + so + 8));
            const bf16x8 p00 = pack8(g00[8 * ss], g00[8 * ss + 1], g00[8 * ss + 2], g00[8 * ss + 3], g00[8 * ss + 4], g00[8 * ss + 5], g00[8 * ss + 6], g00[8 * ss + 7]);
            const bf16x8 p01 = pack8(g01[8 * ss], g01[8 * ss + 1], g01[8 * ss + 2], g01[8 * ss + 3], g01[8 * ss + 4], g01[8 * ss + 5], g01[8 * ss + 6], g01[8 * ss + 7]);
            const bf16x8 p11 = pack8(g11[8 * ss], g11[8 * ss + 1], g11[8 * ss + 2], g11[8 * ss + 3], g11[8 * ss + 4], g11[8 * ss + 5], g11[8 * ss + 6], g11[8 * ss + 7]);
            y00 = MFMA32(xa0, p00, y00); y10 = MFMA32(xa1, p00, y10);
            y01 = MFMA32(xa0, p01, y01); y11 = MFMA32(xa1, p01, y11);
            y01 = MFMA32(xb0, p11, y01); y11 = MFMA32(xb1, p11, y11);
        }
        {
            const int tq0 = t0 + col, tq1 = t0 + 32 + col;
            if (tq0 >= 0 && tq0 < tlim) { float* yp = Y32 + (rbase + tq0) * 384 + h * 64;
#pragma unroll
                for (int gq = 0; gq < 4; ++gq) { *(f32x4*)(yp + 8 * gq + 4 * hi) = (f32x4){y00[4 * gq], y00[4 * gq + 1], y00[4 * gq + 2], y00[4 * gq + 3]};
                    *(f32x4*)(yp + 32 + 8 * gq + 4 * hi) = (f32x4){y10[4 * gq], y10[4 * gq + 1], y10[4 * gq + 2], y10[4 * gq + 3]}; } }
            if (tq1 >= 0 && tq1 < tlim) { float* yp = Y32 + (rbase + tq1) * 384 + h * 64;
#pragma unroll
                for (int gq = 0; gq < 4; ++gq) { *(f32x4*)(yp + 8 * gq + 4 * hi) = (f32x4){y01[4 * gq], y01[4 * gq + 1], y01[4 * gq + 2], y01[4 * gq + 3]};
                    *(f32x4*)(yp + 32 + 8 * gq + 4 * hi) = (f32x4){y11[4 * gq], y11[4 * gq + 1], y11[4 * gq + 2], y11[4 * gq + 3]}; } }
        }
        f32x16 c00, c01, c10, c11;
#pragma unroll
        for (int i = 0; i < 16; ++i) { c00[i] = 0.f; c01[i] = 0.f; c10[i] = 0.f; c11[i] = 0.f; }
#pragma unroll
        for (int ks = 0; ks < 4; ++ks) {
            const int ko = 16 * ks + 8 * hi;
            const bf16x8 xa0 = *(const bf16x8*)(xt + col * 72 + ko), xa1 = *(const bf16x8*)(xt + (32 + col) * 72 + ko);
            const f32x4 wa = *(const f32x4*)(acsl + ko), wb = *(const f32x4*)(acsl + ko + 4), da = *(const f32x4*)(dts + ko), db_ = *(const f32x4*)(dts + ko + 4);
            float w3[8];
#pragma unroll
            for (int j = 0; j < 4; ++j) { w3[j] = da[j] * __expf(acs63 - wa[j]); w3[4 + j] = db_[j] * __expf(acs63 - wb[j]); }
            const u32x4 r0 = *(const u32x4*)(bt + col * 72 + ko), r1 = *(const u32x4*)(bt + (32 + col) * 72 + ko);
            const bf16x8 b0 = pack8(bf_lo(r0.x) * w3[0], bf_hi(r0.x) * w3[1], bf_lo(r0.y) * w3[2], bf_hi(r0.y) * w3[3], bf_lo(r0.z) * w3[4], bf_hi(r0.z) * w3[5], bf_lo(r0.w) * w3[6], bf_hi(r0.w) * w3[7]);
            const bf16x8 b1 = pack8(bf_lo(r1.x) * w3[0], bf_hi(r1.x) * w3[1], bf_lo(r1.y) * w3[2], bf_hi(r1.y) * w3[3], bf_lo(r1.z) * w3[4], bf_hi(r1.z) * w3[5], bf_lo(r1.w) * w3[6], bf_hi(r1.w) * w3[7]);
            c00 = MFMA32(b0, xa0, c00); c01 = MFMA32(b0, xa1, c01); c10 = MFMA32(b1, xa0, c10); c11 = MFMA32(b1, xa1, c11);
        }
        if (grp == 0) { float* sp = ST + ((size_t)(b * NCH + c) * 6 + h) * 4096;
#pragma unroll
            for (int gq = 0; gq < 4; ++gq) { const int n0 = 8 * gq + 4 * hi;
                *(f32x4*)(sp + col * 64 + n0) = (f32x4){c00[4 * gq], c00[4 * gq + 1], c00[4 * gq + 2], c00[4 * gq + 3]};
                *(f32x4*)(sp + (32 + col) * 64 + n0) = (f32x4){c01[4 * gq], c01[4 * gq + 1], c01[4 * gq + 2], c01[4 * gq + 3]};
                *(f32x4*)(sp + col * 64 + 32 + n0) = (f32x4){c10[4 * gq], c10[4 * gq + 1], c10[4 * gq + 2], c10[4 * gq + 3]};
                *(f32x4*)(sp + (32 + col) * 64 + 32 + n0) = (f32x4){c11[4 * gq], c11[4 * gq + 1], c11[4 * gq + 2], c11[4 * gq + 3]}; } }
        else { const size_t so = ((size_t)(l * DB + b) * 6 + h) * 4096; const float* ip = p.state_ssd() + so; float* op = p.out() + OFF_SS + so; const float dec = __expf(acs63);
#pragma unroll
            for (int gq = 0; gq < 4; ++gq) { const int n0 = 8 * gq + 4 * hi;
                *(f32x4*)(op + col * 64 + n0) = *(const f32x4*)(ip + col * 64 + n0) * dec + (f32x4){c00[4 * gq], c00[4 * gq + 1], c00[4 * gq + 2], c00[4 * gq + 3]};
                *(f32x4*)(op + (32 + col) * 64 + n0) = *(const f32x4*)(ip + (32 + col) * 64 + n0) * dec + (f32x4){c01[4 * gq], c01[4 * gq + 1], c01[4 * gq + 2], c01[4 * gq + 3]};
                *(f32x4*)(op + col * 64 + 32 + n0) = *(const f32x4*)(ip + col * 64 + 32 + n0) * dec + (f32x4){c10[4 * gq], c10[4 * gq + 1], c10[4 * gq + 2], c10[4 * gq + 3]};
                *(f32x4*)(op + (32 + col) * 64 + 32 + n0) = *(const f32x4*)(ip + (32 + col) * 64 + 32 + n0) * dec + (f32x4){c11[4 * gq], c11[4 * gq + 1], c11[4 * gq + 2], c11[4 * gq + 3]}; } }
    }
}

DI void ssd_scan(const PV& p, int l) {
    float* ST = (float*)(p.ws() + WS_ST); const float* ACSG = (const float*)(p.ws() + WS_ACS);
    int tid_ = threadIdx.x; asm volatile("" : "+v"(tid_));
    for (int e = blockIdx.x * 512 + tid_; e < NB * 6 * 4096; e += gridDim.x * 512) {
        const int bh = e >> 12, pn = e & 4095, b = bh / 6, h = bh - b * 6;
        float* sp = ST + ((size_t)b * NCH * 6 + h) * 4096 + pn;
        const float* ap = ACSG + ((size_t)b * TP + 15) * 8 + h;
        float cs[NCH], dec[NCH];
#pragma unroll
        for (int j = 0; j < NCH; ++j) { cs[j] = sp[(size_t)j * 24576]; dec[j] = ap[(size_t)j * 512]; }
        float state = 0.f;
#pragma unroll
        for (int j = 0; j < NCH; ++j) { sp[(size_t)j * 24576] = state; state = __expf(dec[j]) * state + cs[j]; }
        p.out()[OFF_SP + ((size_t)(l * NB + b) * 6 + h) * 4096 + pn] = state;
    }
}

DI void ssd_c(const PV& p, int l, int grp, int b, int c, unsigned char* shm) {
    int tid_ = threadIdx.x; asm volatile("" : "+v"(tid_)); const int tid = tid_, wid = tid >> 6, lane = tid & 63, col = lane & 31, hi = lane >> 5;
    const bf16_t* PROJ = (const bf16_t*)(p.ws() + WS_PROJ); const float* Y32 = (const float*)(p.ws() + WS_Y32); const bf16_t* CC = (const bf16_t*)(p.ws() + WS_CC);
    const float* ACSG = (const float*)(p.ws() + WS_ACS); const float* ST = (const float*)(p.ws() + WS_ST); bf16_t* MIX = (bf16_t*)(p.ws() + WS_MIX);
    float* SSQ = (float*)shm;
    const int t0 = grp == 0 ? 64 * c - 48 : 0, tlim = grp == 0 ? TP : DS;
    const size_t rbase = grp == 0 ? (size_t)b * TP : (size_t)MP + b * 32;
    f32x16 y[2][2];
    const int h = wid, g = h / 3;
    int tq[2]; bool vq[2]; size_t rq[2];
#pragma unroll
    for (int qb = 0; qb < 2; ++qb) { const int t = t0 + 32 * qb + col; vq[qb] = t >= 0 && t < tlim; tq[qb] = t < 0 ? 0 : (t >= tlim ? tlim - 1 : t); rq[qb] = rbase + tq[qb]; }
    if (wid < 6) {
        const float* prev = grp == 0 ? ST + ((size_t)(b * NCH + c) * 6 + h) * 4096 : p.state_ssd() + ((size_t)(l * DB + b) * 6 + h) * 4096;
        bf16x8 bq[4][2]; f32x4 pa[4][2][2];
#pragma unroll
        for (int ks = 0; ks < 4; ++ks) {
            const int ko = 16 * ks + 8 * hi;
#pragma unroll
            for (int pb = 0; pb < 2; ++pb) { const float* pp = prev + (32 * pb + col) * 64 + ko; pa[ks][pb][0] = *(const f32x4*)pp; pa[ks][pb][1] = *(const f32x4*)(pp + 4); }
#pragma unroll
            for (int qb = 0; qb < 2; ++qb) bq[ks][qb] = *(const bf16x8*)(CC + rq[qb] * 128 + g * 64 + ko);
        }
        f32x4 yd[2][2][4]; u32x2 zw[2][2][4]; float eqv[2];
#pragma unroll
        for (int qb = 0; qb < 2; ++qb) { eqv[qb] = ACSG[rq[qb] * 8 + h];
#pragma unroll
            for (int pb = 0; pb < 2; ++pb)
#pragma unroll
                for (int gq = 0; gq < 4; ++gq) { const int p0 = 32 * pb + 8 * gq + 4 * hi;
                    yd[qb][pb][gq] = *(const f32x4*)(Y32 + rq[qb] * 384 + h * 64 + p0); zw[qb][pb][gq] = *(const u32x2*)(PROJ + rq[qb] * NPROJ + CZ_ + h * 64 + p0); } }
#pragma unroll
        for (int pb = 0; pb < 2; ++pb)
#pragma unroll
            for (int qb = 0; qb < 2; ++qb)
#pragma unroll
                for (int i = 0; i < 16; ++i) y[pb][qb][i] = 0.f;
#pragma unroll
        for (int ks = 0; ks < 4; ++ks) {
            bf16x8 a[2];
#pragma unroll
            for (int pb = 0; pb < 2; ++pb) { const f32x4 x0 = pa[ks][pb][0], x1 = pa[ks][pb][1]; a[pb] = pack8(x0[0], x0[1], x0[2], x0[3], x1[0], x1[1], x1[2], x1[3]); }
#pragma unroll
            for (int pb = 0; pb < 2; ++pb)
#pragma unroll
                for (int qb = 0; qb < 2; ++qb) y[pb][qb] = MFMA32(a[pb], bq[ks][qb], y[pb][qb]);
        }
#pragma unroll
        for (int qb = 0; qb < 2; ++qb) {
            const float eq = __expf(eqv[qb]); float ssq = 0.f;
#pragma unroll
            for (int pb = 0; pb < 2; ++pb)
#pragma unroll
                for (int gq = 0; gq < 4; ++gq) {
                    const f32x4 ydv = yd[qb][pb][gq]; const u32x2 zv = zw[qb][pb][gq];
                    const float z0 = bf_lo(zv.x), z1 = bf_hi(zv.x), z2 = bf_lo(zv.y), z3 = bf_hi(zv.y);
                    const float v0 = (ydv[0] + eq * y[pb][qb][4 * gq]) * siluf(z0), v1 = (ydv[1] + eq * y[pb][qb][4 * gq + 1]) * siluf(z1);
                    const float v2 = (ydv[2] + eq * y[pb][qb][4 * gq + 2]) * siluf(z2), v3 = (ydv[3] + eq * y[pb][qb][4 * gq + 3]) * siluf(z3);
                    y[pb][qb][4 * gq] = v0; y[pb][qb][4 * gq + 1] = v1; y[pb][qb][4 * gq + 2] = v2; y[pb][qb][4 * gq + 3] = v3;
                    ssq += v0 * v0 + v1 * v1 + v2 * v2 + v3 * v3;
                }
            ssq += __shfl_xor(ssq, 32);
            if (hi == 0) SSQ[h * 64 + 32 * qb + col] = ssq;
        }
    }
    __syncthreads();
    if (wid < 6) {
        const float* gn = p.ssd_norm() + (size_t)l * 384 + h * 64;
#pragma unroll
        for (int qb = 0; qb < 2; ++qb) {
            float tot = 0.f;
#pragma unroll
            for (int hh = 0; hh < 6; ++hh) tot += SSQ[hh * 64 + 32 * qb + col];
            const float rs = rsqrtf(tot * (1.f / 384.f) + EPS);
            if (vq[qb]) {
#pragma unroll
                for (int pb = 0; pb < 2; ++pb)
#pragma unroll
                    for (int gq = 0; gq < 4; ++gq) {
                        const int p0 = 32 * pb + 8 * gq + 4 * hi; const f32x4 gg = *(const f32x4*)(gn + p0);
                        u32x2 w = {pack2(y[pb][qb][4 * gq] * rs * gg[0], y[pb][qb][4 * gq + 1] * rs * gg[1]), pack2(y[pb][qb][4 * gq + 2] * rs * gg[2], y[pb][qb][4 * gq + 3] * rs * gg[3])};
                        *(u32x2*)(MIX + rq[qb] * 1024 + 640 + h * 64 + p0) = w;
                    }
            }
        }
    }
}

DI void kv_out_item(const PV& p, int l, int j) {
    int tid_ = threadIdx.x; asm volatile("" : "+v"(tid_)); const int tid = tid_;
    const bf16_t* PROJ = (const bf16_t*)(p.ws() + WS_PROJ); float* o = p.out();
    float* kp = o + OFF_KP + (size_t)l * MP * 384; float* ks = o + OFF_KS + (size_t)l * MS * 384; float* vp = o + OFF_VP + (size_t)l * MP * 384; float* vs = o + OFF_VS + (size_t)l * MS * 384;
    u32x4 w[12];
#pragma unroll
    for (int i = 0; i < 12; ++i) { const int ch = tid + i * 512, rr = ch / 96, cc = ch - rr * 96; const int r = 64 * j + rr; w[i] = *(const u32x4*)(PROJ + (size_t)(r < MTOT ? r : MTOT - 1) * NPROJ + CK_ + cc * 8); }
#pragma unroll
    for (int i = 0; i < 12; ++i) { const int ch = tid + i * 512, rr = ch / 96, cc = ch - rr * 96; const int r = 64 * j + rr;
        if (r < MTOT) { const bool isP = r < MP; const int rl = isP ? r : r - MP; const int c8 = cc * 8;
            float* d = c8 < 384 ? (isP ? kp : ks) + (size_t)rl * 384 + c8 : (isP ? vp : vs) + (size_t)rl * 384 + (c8 - 384);
            *(f32x4*)d = (f32x4){bf_lo(w[i].x), bf_hi(w[i].x), bf_lo(w[i].y), bf_hi(w[i].y)}; *(f32x4*)(d + 4) = (f32x4){bf_lo(w[i].z), bf_hi(w[i].z), bf_lo(w[i].w), bf_hi(w[i].w)}; } }
}

DI void pool_item(const PV& p, int l, int grp, int b, int j, unsigned char* shm) {
    int tid_ = threadIdx.x; asm volatile("" : "+v"(tid_)); const int tid = tid_, wid = tid >> 6, lane = tid & 63, col = lane & 31, hi = lane >> 5;
    const bf16_t* PROJ = (const bf16_t*)(p.ws() + WS_PROJ); bf16_t* MIX = (bf16_t*)(p.ws() + WS_MIX); const bf16_t* PWT = (const bf16_t*)(p.ws() + WS_PWT);
    float* EXT = (float*)shm; bf16_t* D = (bf16_t*)(shm + 80896);
    const int t0 = 64 * j, tlim = grp == 0 ? TP : DS; const size_t rbase = grp == 0 ? (size_t)b * TP : (size_t)MP + b * 32;
    {
        u32x2 xr[10]; f32x4 xs_[10];
#pragma unroll
        for (int it = 0; it < 10; ++it) {
            const int idx = tid + it * 512, e = idx >> 6, ch = 4 * (idx & 63), t = t0 - 15 + e; xr[it] = (u32x2){0u, 0u}; xs_[it] = (f32x4){0.f, 0.f, 0.f, 0.f};
            if (idx < 79 * 64) {
                if (t >= 0) { if (t < tlim) xr[it] = *(const u32x2*)(PROJ + (rbase + t) * NPROJ + CU_ + ch); }
                else if (grp == 1) xs_[it] = *(const f32x4*)(p.state_pool() + ((size_t)(l * DB + b) * 15 + 15 + t) * 256 + ch);
            }
        }
#pragma unroll
        for (int it = 0; it < 10; ++it) {
            const int idx = tid + it * 512, e = idx >> 6, ch = 4 * (idx & 63);
            if (idx < 79 * 64) *(f32x4*)(EXT + e * 256 + ch) = xs_[it] + (f32x4){bf_lo(xr[it].x), bf_hi(xr[it].x), bf_lo(xr[it].y), bf_hi(xr[it].y)};
        }
    }
    __syncthreads();
    { const int ch = tid & 255, half = tid >> 8, g = ch >> 6, w = 2 << g;
      for (int s = half * 32; s < half * 32 + 32; ++s) {
          float sum = 0.f; for (int k = 0; k < w; ++k) sum += EXT[(s + 15 - k) * 256 + ch];
          const int t = t0 + s; const int cnt = grp == 0 ? (t + 1 < w ? t + 1 : w) : w;
          D[s * 264 + ch] = f2bf(sum / (float)cnt - EXT[(s + 15) * 256 + ch]);
      } }
    __syncthreads();
    { const int g = wid >> 1, sb = wid & 1; f32x16 y0, y1;
#pragma unroll
      for (int i = 0; i < 16; ++i) { y0[i] = 0.f; y1[i] = 0.f; }
      const bf16_t* wp = PWT + (size_t)(l * 4 + g) * 4096;
#pragma unroll
      for (int ks = 0; ks < 4; ++ks) {
          const int ko = 16 * ks + 8 * hi;
          const bf16x8 a0 = *(const bf16x8*)(wp + col * 64 + ko), a1 = *(const bf16x8*)(wp + (32 + col) * 64 + ko);
          const bf16x8 bq = *(const bf16x8*)(D + (32 * sb + col) * 264 + g * 64 + ko);
          y0 = MFMA32(a0, bq, y0); y1 = MFMA32(a1, bq, y1);
      }
      const int t = t0 + 32 * sb + col;
      if (t < tlim) { bf16_t* op = MIX + (rbase + t) * 1024 + 384 + g * 64; const float* sc = p.pool_scale() + (size_t)l * 256 + g * 64;
#pragma unroll
          for (int gq = 0; gq < 4; ++gq) { const int e0 = 8 * gq + 4 * hi; const f32x4 s0 = *(const f32x4*)(sc + e0), s1 = *(const f32x4*)(sc + 32 + e0);
              u32x2 w0 = {pack2(y0[4 * gq] * s0[0], y0[4 * gq + 1] * s0[1]), pack2(y0[4 * gq + 2] * s0[2], y0[4 * gq + 3] * s0[3])};
              u32x2 w1 = {pack2(y1[4 * gq] * s1[0], y1[4 * gq + 1] * s1[1]), pack2(y1[4 * gq + 2] * s1[2], y1[4 * gq + 3] * s1[3])};
              *(u32x2*)(op + e0) = w0; *(u32x2*)(op + 32 + e0) = w1; } }
    }
}
#ifndef REP_P0
#define REP_P0 1
#endif
#ifndef REP_SSDC
#define REP_SSDC 1
#endif
#ifndef REP_P2
#define REP_P2 1
#endif
#ifndef REP_GEMM
#define REP_GEMM 1
#endif
#ifndef REP_SYNC
#define REP_SYNC 1
#endif
#ifndef PHMASK
#define PHMASK 8191
#endif
DI int next_item(unsigned* ctr, int* slot) { __syncthreads(); if (threadIdx.x == 0) *slot = (int)atomicAdd(ctr, 1u); __syncthreads(); return *slot; }
constexpr int N_ATT_P = 24 * 17, N_ATT_S = DB * 6, N_SSD = NB * NCH + DB, N_POOL = NB * NCH + DB, N_KV = MTOT / 64, N_P2 = N_ATT_P + N_ATT_S + N_SSD + N_POOL + N_KV;
constexpr size_t LDS_BYTES = 131072 + 1024;

__global__ void __launch_bounds__(512, 2) hymba_fwd(Params params) {
    const PV p{};
    extern __shared__ __attribute__((aligned(16))) unsigned char shm[];
    cg::grid_group grid = cg::this_grid();
    int* slot = (int*)(shm + 131072);
    volatile LAS unsigned* xst = (volatile LAS unsigned*)(PG8_LAS unsigned char*)(shm + 131072 + 16);
    if (threadIdx.x == 0) { xst[0] = 0u; xst[1] = 0u; }
    __syncthreads();
    (void)xcd_barrier_post((unsigned*)(p.ws() + WS_BAR), xst);
    PG8_LAS unsigned char* lds = (PG8_LAS unsigned char*)shm;


    for (int ph = 0; ph < 1 + 9 * DEPTH; ++ph) {
        const int l = ph == 0 ? 0 : (ph - 1) / 9, k = ph == 0 ? -1 : (ph - 1) % 9;
        switch (k) {
        case -1:
#if PHMASK & 1
 for (int rep = 0; rep < REP_P0; ++rep) { phase0_weights(p, shm); row_phase(p, 0, nullptr, false, 0); }
#endif
 break;
        case 0: {
            pg8::Gemm g{(const bf16_t*)(p.ws() + WS_H), (const bf16_t*)(p.ws() + WS_WIN + l * SZ_WIN), MPAD, NPROJ, 1024};
            pg8::StaticOrder S; S.init(MPAD, NPROJ, (int)gridDim.x, (int)blockIdx.x, 1024);
            float* o = p.out();
            EpiIn E{(bf16_t*)(p.ws() + WS_PROJ), (bf16_t*)(p.ws() + WS_VT), (float*)(p.ws() + WS_DT), p.fox_f_bias() + l * 6, p.dt_bias() + l * 6, (const float*)(p.ws() + WS_RSTD),
                    o + OFF_KP + (size_t)l * MP * 384, o + OFF_KS + (size_t)l * MS * 384, o + OFF_VP + (size_t)l * MP * 384, o + OFF_VS + (size_t)l * MS * 384,
                    o + OFF_LP + (size_t)l * MP * 6, o + OFF_LS + (size_t)l * MS * 6, o + OFF_PP + (size_t)l * NB * 15 * 256, o + OFF_PS + (size_t)l * DB * 15 * 256,
                    o + OFF_CP + (size_t)l * NB * 3 * 640, o + OFF_CS + (size_t)l * DB * 3 * 640};
#if PHMASK & 2
            for (int rep = 0; rep < REP_GEMM; ++rep) pg8::gemm_phase<EpiIn, pg8::StaticOrder, false>(lds, g, S, E, nullptr);
#endif
        } break;
        case 1:
          for (int rep = 0; rep < REP_P2; ++rep) {
            unsigned* qctr = (unsigned*)(p.ws() + WS_CTR) + l + 8 * rep;
            int nxt = 0; if (threadIdx.x == 0) nxt = (int)atomicAdd(qctr, 1u);
            for (;;) {
                __syncthreads(); if (threadIdx.x == 0) *slot = nxt; __syncthreads();
                const int it = *slot;
                if (it >= N_P2) break;
                if (threadIdx.x == 0) nxt = (int)atomicAdd(qctr, 1u);
                if (it < N_ATT_P) { const int qi = 16 - it / 24, bh = it % 24;
#if PHMASK & 4
if (attn_prompt_fast(p, l, bh / 6, bh % 6, qi, shm)) attn_prompt(p, l, bh / 6, bh % 6, qi, shm);
#endif
 }
                else if (it < N_ATT_P + N_ATT_S) { const int a = it - N_ATT_P;
#if PHMASK & 8
attn_sample(p, l, a / 6, a % 6, shm);
#endif
 }
                else if (it < N_ATT_P + N_ATT_S + N_SSD) { const int j = it - N_ATT_P - N_ATT_S; const int grp = j < NB * NCH ? 0 : 1; const int b = grp == 0 ? j / NCH : j - NB * NCH, c = grp == 0 ? j % NCH : 0;
#if PHMASK & 16
ssd_a(p, l, grp, b, c, shm);
#endif
 }
                else if (it >= N_ATT_P + N_ATT_S + N_SSD + N_POOL) kv_out_item(p, l, it - N_ATT_P - N_ATT_S - N_SSD - N_POOL);
                else { const int j = it - N_ATT_P - N_ATT_S - N_SSD; const int grp = j < NB * NCH ? 0 : 1; const int b = grp == 0 ? j / NCH : j - NB * NCH, c = grp == 0 ? j % NCH : 0;
#if PHMASK & 32
pool_item(p, l, grp, b, c, shm);
#endif
 }
            }
          }
            break;
        case 2:
#if PHMASK & 64
 ssd_scan(p, l);
#endif
 break;
        case 3:
          for (int rep = 0; rep < REP_SSDC; ++rep)
            for (int j = blockIdx.x; j < N_SSD; j += gridDim.x) {
                const int grp = j < NB * NCH ? 0 : 1; const int b = grp == 0 ? j / NCH : j - NB * NCH, c = grp == 0 ? j % NCH : 0;
#if PHMASK & 128
                ssd_c(p, l, grp, b, c, shm); __syncthreads();
#endif
            }
            break;
        case 4: {
            pg8::Gemm g{(const bf16_t*)(p.ws() + WS_MIX), (const bf16_t*)(p.ws() + WS_WOUT + l * SZ_WOUT), MPAD, 1024, 1024};
            SplitOrder S{4, 16, (int)gridDim.x, (int)blockIdx.x};
            EpiOutB E{(bf16_t*)(p.ws() + WS_OUT), (float*)(p.ws() + WS_PART)};
#if PHMASK & 256
            for (int rep = 0; rep < REP_GEMM; ++rep) pg8::gemm_phase<EpiOutB, SplitOrder, false>(lds, g, S, E, nullptr);
#endif
        } break;
        case 5:
#if PHMASK & 512

#ifdef REP_ROW
 row_phase(p, 1, p.ln_post_mix() + (size_t)l * 1024, false, 4, true);
#endif
 row_phase(p, 1, p.ln_post_mix() + (size_t)l * 1024, false, 4);
#endif
 break;
        case 6: {
            pg8::Gemm g{(const bf16_t*)(p.ws() + WS_H), (const bf16_t*)(p.ws() + WS_WGU + l * SZ_WGU), MPAD, 2 * DFF, 1024};
            pg8::StaticOrder S; S.init(MPAD, 2 * DFF, (int)gridDim.x, (int)blockIdx.x, 1024);
            EpiGU E{(bf16_t*)(p.ws() + WS_HID), (const float*)(p.ws() + WS_RSTD)};
#if PHMASK & 1024
            for (int rep = 0; rep < REP_GEMM; ++rep) pg8::gemm_phase<EpiGU, pg8::StaticOrder, false>(lds, g, S, E, nullptr);
#endif
        } break;
        case 7: {
            pg8::Gemm g{(const bf16_t*)(p.ws() + WS_HID), (const bf16_t*)(p.ws() + WS_WDN + l * SZ_WDN), MPAD, 1024, DFF};
            SplitOrder S{11, 44, (int)gridDim.x, (int)blockIdx.x};
            EpiOutB E{(bf16_t*)(p.ws() + WS_OUT), (float*)(p.ws() + WS_PART)};
#if PHMASK & 2048
            for (int rep = 0; rep < REP_GEMM; ++rep) pg8::gemm_phase<EpiOutB, SplitOrder, false>(lds, g, S, E, nullptr);
#endif
        } break;
        default:
#if PHMASK & 4096

#ifdef REP_ROW
 row_phase(p, 1, p.ln_post_ffn() + (size_t)l * 1024, false, 11, true);
#endif
 row_phase(p, 1, p.ln_post_ffn() + (size_t)l * 1024, l + 1 == DEPTH, 11);
#endif
 break;
        }
        if (ph + 1 < 1 + 9 * DEPTH) { for (int rep = 0; rep < REP_SYNC; ++rep) {
            if (ph == 0) grid.sync();
            else { XcdBarrier xb; xb.bar = (unsigned*)(p.ws() + WS_BAR); xb.x = xb_xcc_id(); xb.st = xst; xcd_barrier(xb); } } }
    }
}

extern "C" void kernel_launch(void* const* d_in, const int* in_sizes, int n_in, void* d_out, int out_size, void* d_ws, size_t ws_size, hipStream_t stream) {
    static int grid_blocks = 0;
    if (!grid_blocks) {
        if (hipFuncSetAttribute((const void*)hymba_fwd, hipFuncAttributeMaxDynamicSharedMemorySize, (int)LDS_BYTES) != hipSuccess) { fprintf(stderr, "hipFuncSetAttribute failed\n"); return; }
        int dev = 0, cus = 0, per_cu = 0;
        (void)hipGetDevice(&dev);
        (void)hipDeviceGetAttribute(&cus, hipDeviceAttributeMultiprocessorCount, dev);
        if (hipOccupancyMaxActiveBlocksPerMultiprocessor(&per_cu, (const void*)hymba_fwd, 512, LDS_BYTES) != hipSuccess || per_cu < 1) { fprintf(stderr, "occupancy query failed\n"); return; }
        grid_blocks = cus * 1;
    }
    if (ws_size < WS_END) { fprintf(stderr, "workspace too small\n"); return; }
    Params p{};
    const float* const* in = (const float* const*)d_in;
    p.x_prompt = in[0]; p.x_sample = in[1]; p.cache_k = in[2]; p.cache_v = in[3]; p.cache_logf = in[4]; p.state_pool = in[5]; p.state_conv = in[6]; p.state_ssd = in[7];
    p.meta = in[8]; p.ln_pre_mix = in[9]; p.ln_post_mix = in[10]; p.ln_pre_ffn = in[11]; p.ln_post_ffn = in[12]; p.w_in = in[13]; p.fox_f_bias = in[14]; p.pool_w = in[15];
    p.pool_scale = in[16]; p.conv_w = in[17]; p.conv_b = in[18]; p.dt_bias = in[19]; p.a_log = in[20]; p.d_skip = in[21]; p.ssd_norm = in[22]; p.w_out = in[23];
    p.w_gate = in[24]; p.w_up = in[25]; p.w_down = in[26];
    p.out = (float*)d_out; p.ws = (unsigned char*)d_ws;
    (void)hipMemsetAsync((unsigned char*)d_ws + WS_CTR, 0, 4096 + 16384, stream);
    void* args[] = {&p};
    hipError_t e = hipLaunchCooperativeKernel((const void*)hymba_fwd, dim3(grid_blocks), dim3(512), args, LDS_BYTES, stream);
    if (e != hipSuccess) fprintf(stderr, "cooperative launch failed: %s (grid %d)\n", hipGetErrorString(e), grid_blocks);
}
```
